# Optimizing an MI355X kernel written in HIP

```python
import functools
import jax, jax.numpy as jnp
from jax import lax
import numpy as np

D_MODEL = 1024
BATCH = 8
SEQ = 2048
DEPTH = 4
DEC_BATCH = 128
DEC_SEQ = 4
PAST_LEN = 16384
PAGE_SIZE = 128

MIX_WIDTH = D_MODEL
HG_HEADS = 4
HG_DK = MIX_WIDTH // 2 // HG_HEADS
HG_DV = HG_DK
RT_HEADS = 4
RT_DK = MIX_WIDTH // 2 // RT_HEADS
RT_DV = RT_DK
HG_W = HG_HEADS * HG_DK
RT_W = RT_HEADS * RT_DK
PROJ_COLS = 4 * HG_W + 4 * RT_W
SPLITS = [HG_W, 2 * HG_W, 3 * HG_W, 4 * HG_W, 4 * HG_W + RT_W, 4 * HG_W + 2 * RT_W, 4 * HG_W + 3 * RT_W]
N_META = 16
CHUNK = 64
CONV_W = 3
D_FF = 2816
ROPE_BASE = 10000.0
LN_EPS = 1e-5
F_EPS = 1e-6
ALPHA = (2 * DEPTH) ** 0.25
BETA = (8 * DEPTH) ** -0.25

kernel_name = 'hymba_hgrn2_retention_convffn_step'


def layer_norm(x, g, b):
    xf = x.astype(jnp.float32)
    mu = jnp.mean(xf, -1, keepdims=True)
    var = jnp.mean(jnp.square(xf - mu), -1, keepdims=True)
    return ((xf - mu) * lax.rsqrt(var + LN_EPS) * g + b).astype(x.dtype)


def head_rms_norm(o):
    return o * lax.rsqrt(jnp.mean(jnp.square(o), -1, keepdims=True) + LN_EPS)


def head_group_norm(o):
    mu = jnp.mean(o, -1, keepdims=True)
    var = jnp.mean(jnp.square(o - mu), -1, keepdims=True)
    return (o - mu) * lax.rsqrt(var + LN_EPS)


def rotary(x, pos):
    half = x.shape[-1] // 2
    inv = ROPE_BASE ** (-jnp.arange(half, dtype=jnp.float32) / half)
    ang = pos.astype(jnp.float32)[:, None] * inv[None, :]
    cos = jnp.cos(ang)[None, :, None, :]
    sin = jnp.sin(ang)[None, :, None, :]
    x1, x2 = x[..., :half], x[..., half:]
    return jnp.concatenate([x1 * cos - x2 * sin, x1 * sin + x2 * cos], -1)


def hgrn2_block(s0, q, k, v, log_f):
    c = q.shape[1]
    b = jnp.cumsum(log_f, axis=1)
    causal = jnp.tril(jnp.ones((c, c), bool))[None, :, :, None, None]
    diff = jnp.where(causal, b[:, :, None] - b[:, None, :], 0.0)
    decay = jnp.where(causal, jnp.exp(diff), 0.0)
    scores = jnp.einsum('bthk,btshk,bshk->bhts', q, decay, k)
    o = jnp.einsum('bhts,bshv->bthv', scores, v) + jnp.einsum('bthk,bhkv->bthv', q * jnp.exp(b), s0)
    b_last = b[:, -1]
    s_new = jnp.exp(b_last)[..., None] * s0 + jnp.einsum('bshk,bshv->bhkv', k * jnp.exp(b_last[:, None] - b), v)
    return s_new, o


def retention_block(s0, q, k, v):
    c = q.shape[1]
    log_gamma = jnp.log1p(-jnp.exp2(-5.0 - jnp.arange(RT_HEADS, dtype=jnp.float32)))
    idx = jnp.arange(c, dtype=jnp.float32)
    rel = idx[:, None] - idx[None, :]
    mask = (rel >= 0)[None]
    decay = jnp.where(mask, jnp.exp(jnp.where(mask, rel[None] * log_gamma[:, None, None], 0.0)), 0.0)
    scores = jnp.einsum('bthk,bshk->bhts', q, k) * decay[None]
    q_dec = jnp.exp((idx + 1.0)[:, None] * log_gamma[None, :])
    o = jnp.einsum('bhts,bshv->bthv', scores, v) + jnp.einsum('bthk,bhkv->bthv', q, s0) * q_dec[None, :, :, None]
    k_dec = jnp.exp((c - 1.0 - idx)[:, None] * log_gamma[None, :])
    s_new = jnp.exp(c * log_gamma)[None, :, None, None] * s0 + jnp.einsum('bshk,bshv->bhkv', k * k_dec[None, :, :, None], v)
    return s_new, o


def mix_sequence(block_fn, s0, arrays, lead):
    s, o_lead = block_fn(s0, *(a[:, :lead] for a in arrays))
    rest = tuple(a[:, lead:] for a in arrays)
    n_blocks = rest[0].shape[1] // CHUNK
    if n_blocks == 0:
        return s, o_lead

    def to_blocks(a):
        return jnp.swapaxes(a.reshape(a.shape[0], n_blocks, CHUNK, *a.shape[2:]), 0, 1)

    s, o_rest = lax.scan(lambda st, xs: block_fn(st, *xs), s, tuple(to_blocks(a) for a in rest))
    o_rest = jnp.swapaxes(o_rest, 0, 1).reshape(o_lead.shape[0], n_blocks * CHUNK, *o_lead.shape[2:])
    return s, jnp.concatenate([o_lead, o_rest], axis=1)


def token_mixer(x, pos, s_hg, s_rt, lead, lb, w_in, hg_norm_g, rt_gn_g, rt_gn_b, w_o):
    bsz, t, _ = x.shape
    f32 = jnp.float32
    proj = jnp.einsum('btd,dc->btc', x, w_in).astype(f32)
    hq, hf, hv, hg, rq, rk, rv, rg = jnp.split(proj, SPLITS, axis=-1)

    def heads(a, h):
        return a.reshape(bsz, t, h, -1)

    f_gate = lb + (1.0 - lb) * jax.nn.sigmoid(hf)
    log_f = jnp.log(jnp.maximum(f_gate, F_EPS))
    k_hg = (1.0 - lb) * jax.nn.sigmoid(-hf)
    s_hg, o_hg = mix_sequence(hgrn2_block, s_hg.astype(f32),
                              (heads(jax.nn.silu(hq), HG_HEADS), heads(k_hg, HG_HEADS),
                               heads(hv, HG_HEADS), heads(log_f, HG_HEADS)), lead)
    o_hg = head_rms_norm(o_hg).reshape(bsz, t, HG_W) * hg_norm_g * jax.nn.silu(hg)

    q_r = rotary(heads(rq, RT_HEADS), pos)
    k_r = rotary(heads(rk, RT_HEADS), pos) * (RT_DK ** -0.5)
    s_rt, o_rt = mix_sequence(retention_block, s_rt.astype(f32), (q_r, k_r, heads(rv, RT_HEADS)), lead)
    o_rt = (head_group_norm(o_rt).reshape(bsz, t, RT_W) * rt_gn_g + rt_gn_b) * jax.nn.silu(rg)

    o = jnp.concatenate([o_hg, o_rt], axis=-1).astype(x.dtype)
    return jnp.einsum('btc,cd->btd', o, w_o), s_hg, s_rt


def conv_ffn(x, conv_buf, w_a, w_b, conv_w, conv_b, w_down):
    a = jnp.einsum('btd,df->btf', x, w_a)
    g = jnp.einsum('btd,df->btf', x, w_b)
    t = a.shape[1]
    a_ext = jnp.concatenate([conv_buf.astype(a.dtype), a], axis=1)
    conv = conv_b + sum(conv_w[j] * a_ext[:, j:j + t] for j in range(CONV_W))
    h = jax.nn.gelu(conv) * g
    return jnp.einsum('btf,fd->btd', h, w_down), a_ext[:, -(CONV_W - 1):]


def trunk(x, pos, lead, s_hg, s_rt, s_conv, lb_all, w_in, hg_norm_g, rt_gn_g, rt_gn_b, w_o,
          ln1_g, ln1_b, w_a, w_b, conv_w, conv_b, w_down, ln2_g, ln2_b):
    new_hg, new_rt, new_conv = [], [], []
    for l in range(DEPTH):
        mix, h_state, r_state = token_mixer(x, pos, s_hg[l], s_rt[l], lead, lb_all[l], w_in[l],
                                            hg_norm_g[l], rt_gn_g[l], rt_gn_b[l], w_o[l])
        x = layer_norm(ALPHA * x + mix, ln1_g[l], ln1_b[l])
        ffn, c_state = conv_ffn(x, s_conv[l], w_a[l], w_b[l], conv_w[l], conv_b[l], w_down[l])
        x = layer_norm(ALPHA * x + ffn, ln2_g[l], ln2_b[l])
        new_hg.append(h_state)
        new_rt.append(r_state)
        new_conv.append(c_state)
    return x, jnp.stack(new_hg), jnp.stack(new_rt), jnp.stack(new_conv)


def setup_inputs(seed: int = 0) -> dict:
    key = jax.random.key(seed)
    ks = jax.random.split(key, 24)
    f32 = jnp.float32

    def nrm(k, shape, s):
        return jax.random.normal(k, shape, f32) * s

    col_scale = jnp.concatenate([jnp.ones((2 * HG_W,), f32), jnp.full((HG_W,), BETA, f32), jnp.ones((HG_W,), f32),
                                 jnp.ones((2 * RT_W,), f32), jnp.full((RT_W,), BETA, f32), jnp.ones((RT_W,), f32)])
    return {
        'x_prompt': nrm(ks[0], (BATCH, SEQ, D_MODEL), 1.0),
        'x_sample': nrm(ks[1], (DEC_BATCH, DEC_SEQ, D_MODEL), 1.0),
        'state_hgrn': nrm(ks[2], (DEPTH, DEC_BATCH, HG_HEADS, HG_DK, HG_DV), 0.5),
        'state_ret': nrm(ks[3], (DEPTH, DEC_BATCH, RT_HEADS, RT_DK, RT_DV), 1.0),
        'state_conv': nrm(ks[4], (DEPTH, DEC_BATCH, CONV_W - 1, D_FF), 1.0),
        'meta_tokens': nrm(ks[5], (N_META, D_MODEL), 1.0),
        'emb_ln_g': 1.0 + nrm(ks[6], (D_MODEL,), 0.02),
        'emb_ln_b': nrm(ks[7], (D_MODEL,), 0.02),
        'lb_logits': nrm(ks[8], (DEPTH, HG_W), 0.5),
        'w_in': nrm(ks[9], (DEPTH, D_MODEL, PROJ_COLS), D_MODEL ** -0.5) * col_scale,
        'hg_norm_g': 1.0 + nrm(ks[10], (DEPTH, HG_W), 0.02),
        'rt_gn_g': 1.0 + nrm(ks[11], (DEPTH, RT_W), 0.02),
        'rt_gn_b': nrm(ks[12], (DEPTH, RT_W), 0.02),
        'w_o': nrm(ks[13], (DEPTH, MIX_WIDTH, D_MODEL), MIX_WIDTH ** -0.5 * BETA),
        'ln1_g': 1.0 + nrm(ks[14], (DEPTH, D_MODEL), 0.02),
        'ln1_b': nrm(ks[15], (DEPTH, D_MODEL), 0.02),
        'w_a': nrm(ks[16], (DEPTH, D_MODEL, D_FF), D_MODEL ** -0.5),
        'w_b': nrm(ks[17], (DEPTH, D_MODEL, D_FF), D_MODEL ** -0.5),
        'conv_w': nrm(ks[18], (DEPTH, CONV_W, D_FF), CONV_W ** -0.5),
        'conv_b': nrm(ks[19], (DEPTH, D_FF), 0.02),
        'w_down': nrm(ks[20], (DEPTH, D_FF, D_MODEL), D_FF ** -0.5 * BETA),
        'ln2_g': 1.0 + nrm(ks[21], (DEPTH, D_MODEL), 0.02),
        'ln2_b': nrm(ks[22], (DEPTH, D_MODEL), 0.02),
    }


def reference(x_prompt, x_sample, state_hgrn, state_ret, state_conv, meta_tokens, emb_ln_g, emb_ln_b,
              lb_logits, w_in, hg_norm_g, rt_gn_g, rt_gn_b, w_o, ln1_g, ln1_b, w_a, w_b, conv_w, conv_b,
              w_down, ln2_g, ln2_b):
    sm = jax.nn.softmax(lb_logits.astype(jnp.float32), axis=0)
    lb_all = jnp.cumsum(sm, axis=0) - sm[0:1]
    weights = (lb_all, w_in, hg_norm_g, rt_gn_g, rt_gn_b, w_o, ln1_g, ln1_b,
               w_a, w_b, conv_w, conv_b, w_down, ln2_g, ln2_b)

    bsz, seq = x_prompt.shape[0], x_prompt.shape[1]
    meta = jnp.broadcast_to(meta_tokens.astype(x_prompt.dtype)[None], (bsz, N_META, D_MODEL))
    xp = layer_norm(jnp.concatenate([meta, x_prompt], axis=1), emb_ln_g, emb_ln_b)
    pos_p = jnp.arange(N_META + seq, dtype=jnp.int32)
    zero_hg = jnp.zeros((DEPTH, bsz, HG_HEADS, HG_DK, HG_DV), jnp.float32)
    zero_rt = jnp.zeros((DEPTH, bsz, RT_HEADS, RT_DK, RT_DV), jnp.float32)
    zero_conv = jnp.zeros((DEPTH, bsz, CONV_W - 1, D_FF), x_prompt.dtype)
    yp, hg_p, rt_p, conv_p = trunk(xp, pos_p, N_META, zero_hg, zero_rt, zero_conv, *weights)
    y_prompt = yp[:, N_META:]

    xs = layer_norm(x_sample, emb_ln_g, emb_ln_b)
    pos_s = PAST_LEN + jnp.arange(x_sample.shape[1], dtype=jnp.int32)
    y_sample, hg_s, rt_s, conv_s = trunk(xs, pos_s, x_sample.shape[1], state_hgrn, state_ret, state_conv, *weights)

    return (y_prompt, y_sample, hg_p, hg_s, rt_p, rt_s, conv_p, conv_s)
```

```cpp
#include <hip/hip_runtime.h>
#include <cstdio>
#include <cstdint>
namespace pg8 {
#define PG8_LAS __attribute__((address_space(3)))
typedef unsigned short bf16_t;
typedef short bf16x8 __attribute__((ext_vector_type(8)));
typedef float f32x4 __attribute__((ext_vector_type(4)));
typedef unsigned u32x4 __attribute__((ext_vector_type(4)));
constexpr int BM = 256, BK = 64, HALF = 128, HTB = HALF * BK * 2  , STAGE_BYTES = 8 * HTB, NXCD = 8, WGM = 8;

__host__ __device__ __forceinline__ int lds_byte(int r, int c) { const int st = (r >> 4) * 2 + (c >> 5), rr = r & 15, cc = c & 31, ob = rr * 64 + cc * 2; return st * 1024 + (ob ^ (((ob >> 9) & 1) << 5)); }
__host__ __device__ __forceinline__ void stage_rc(int b, int& R, int& C) { const int st = b / 1024, sb = b % 1024, swz = sb ^ (((sb >> 9) & 1) << 5); R = (st >> 1) * 16 + swz / 64; C = (st & 1) * 32 + (swz % 64) / 2; }
__host__ __device__ __forceinline__ int perm32(int rho) { const int n = rho >> 4, i = rho & 15; return 8 * (i >> 2) + 4 * n + (i & 3); }

struct Unit { int pm, pn; };
struct Gemm { const bf16_t* A; const bf16_t* Bt; int M, N, K; };

struct StaticOrder {
    int nM, nN, nwg, G, c;
    __host__ __device__ void init(int M, int N, int G_, int c_) { nM = M / BM; nN = N / BM; nwg = nM * nN; G = G_; c = c_; }
    __host__ __device__ bool next(int i, Unit& u) const {
        const long L = (long)i * G + c; if (L >= nwg) return false;
        int wgid = (int)L; { const int q = nwg / NXCD, r = nwg % NXCD, xcd = wgid % NXCD, off = wgid / NXCD; wgid = (xcd < r ? xcd * (q + 1) : r * (q + 1) + (xcd - r) * q) + off; }
        const int nig = WGM * nN, gid = wgid / nig, fm = gid * WGM, gsz = (nM - fm) < WGM ? (nM - fm) : WGM;
        u.pm = fm + ((wgid % nig) % gsz); u.pn = (wgid % nig) / gsz; return true;
    }
    __device__ __forceinline__ void a_ready(const Unit&) const {}
    __device__ __forceinline__ void done(const Unit&) const {}
};

__device__ __forceinline__ unsigned cvt_pk_bf16(float lo, float hi) { unsigned r; asm volatile("v_cvt_pk_bf16_f32 %0, %1, %2" : "=v"(r) : "v"(lo), "v"(hi)); return r; }
template <class Epi, class Sched, bool ALIGN_EPI = false, bool SP2 = false>
__device__ __forceinline__ void gemm_phase(PG8_LAS unsigned char* lds, const Gemm g, const Sched& S, const Epi& E) {
    int tid_ = threadIdx.x; asm volatile("" : "+v"(tid_));
    const int tid = tid_, wid = __builtin_amdgcn_readfirstlane(tid >> 6), lane = tid & 63, wr = wid >> 2, wc = wid & 3, fr = lane & 15, fq = lane >> 4;
    const int K = g.K, nt = K / BK;
    unsigned voffA[2], voffB[2];
#pragma unroll
    for (int i = 0; i < 2; ++i) { int R, C; stage_rc(tid * 16 + i * 8192, R, C); const int Rb = Epi::PERM ? ((R & ~31) + perm32(R & 31)) : R;
        voffA[i] = (unsigned)(R * K + C) * 2u; voffB[i] = (unsigned)(Rb * K + C) * 2u; }
    const size_t kstep = (size_t)(BK * 2);
    const size_t hstep = (size_t)HALF * K * 2;
    const size_t tstep = 2 * hstep;
    const unsigned ldsw = (unsigned)wid * 1024u;
    const int aoff = lds_byte(wr * 64 + fr, fq * 8), boff = lds_byte(wc * 32 + fr, fq * 8);
#define PG8_SA(b, h) (((b) * 2 + (h)) * HTB)
#define PG8_SB(b, h) ((4 + (b) * 2 + (h)) * HTB)
#define PG8_STAGE(bufoff, gbase, voff) do { _Pragma("unroll") for (int _i = 0; _i < 2; ++_i) \
        __builtin_amdgcn_global_load_lds((const unsigned*)((const char*)(gbase) + (voff)[_i]), (PG8_LAS unsigned*)(lds + (bufoff) + ldsw + _i * 8192), 16, 0, 0); } while (0)
#define PG8_LDA(dst, b, h) do { _Pragma("unroll") for (int m = 0; m < 4; ++m) _Pragma("unroll") for (int k = 0; k < 2; ++k) dst[m][k] = *(const PG8_LAS bf16x8*)(lds + PG8_SA(b, h) + aoff + m * 2048 + k * 1024); } while (0)
#define PG8_LDB(dst, b, h) do { _Pragma("unroll") for (int n = 0; n < 2; ++n) _Pragma("unroll") for (int k = 0; k < 2; ++k) dst[n][k] = *(const PG8_LAS bf16x8*)(lds + PG8_SB(b, h) + boff + n * 2048 + k * 1024); } while (0)
#define PG8_MMA(ai, bj, At, Bt) do { __builtin_amdgcn_s_setprio(1); _Pragma("unroll") for (int m = 0; m < 4; ++m) _Pragma("unroll") for (int n = 0; n < 2; ++n) _Pragma("unroll") for (int k = 0; k < 2; ++k) \
        acc[ai][bj][m][n] = __builtin_amdgcn_mfma_f32_16x16x32_bf16(Bt[n][k], At[m][k], acc[ai][bj][m][n], 0, 0, 0); __builtin_amdgcn_s_setprio(0); } while (0)
#define PG8_WAIT_V(n) asm volatile("s_waitcnt vmcnt(" #n ")" ::: "memory")
#define PG8_WAIT_L(n) asm volatile("s_waitcnt lgkmcnt(" #n ")" ::: "memory")
#define PG8_BAR __builtin_amdgcn_s_barrier()
#define PG8_SCHED __builtin_amdgcn_sched_barrier(0)
    Unit cur, nxt; int ui = 0;
    if (!S.next(0, cur)) return;
    f32x4 acc[2][2][4][2];
#pragma unroll
    for (int a = 0; a < 2; ++a)
#pragma unroll
        for (int b = 0; b < 2; ++b)
#pragma unroll
            for (int m = 0; m < 4; ++m)
#pragma unroll
                for (int n = 0; n < 2; ++n) acc[a][b][m][n] = (f32x4){0.f, 0.f, 0.f, 0.f};
    bf16x8 At[4][2], B0[2][2], B1[2][2];
    const char* cA = (const char*)g.A + (size_t)cur.pm * tstep; const char* cB = (const char*)g.Bt + (size_t)cur.pn * tstep;
    S.a_ready(cur);
    if constexpr (SP2) {
        PG8_STAGE(PG8_SB(0, 0), cB, voffB); PG8_STAGE(PG8_SB(0, 1), cB + hstep, voffB); PG8_STAGE(PG8_SA(0, 0), cA, voffA); PG8_STAGE(PG8_SA(0, 1), cA + hstep, voffA);
        if (wr == 1) PG8_BAR;
        PG8_WAIT_V(2); PG8_BAR;
        PG8_STAGE(PG8_SB(1, 0), cB + kstep, voffB); PG8_STAGE(PG8_SA(1, 0), cA + kstep, voffA); PG8_STAGE(PG8_SB(1, 1), cB + hstep + kstep, voffB);
        PG8_WAIT_V(6); PG8_BAR;
    } else {
        PG8_STAGE(PG8_SB(0, 0), cB, voffB); PG8_STAGE(PG8_SA(0, 0), cA, voffA); PG8_STAGE(PG8_SB(0, 1), cB + hstep, voffB); PG8_STAGE(PG8_SA(0, 1), cA + hstep, voffA);
        if (wr == 1) PG8_BAR;
        PG8_WAIT_V(4); PG8_BAR;
        PG8_STAGE(PG8_SB(1, 0), cB + kstep, voffB); PG8_STAGE(PG8_SA(1, 0), cA + kstep, voffA); PG8_STAGE(PG8_SB(1, 1), cB + hstep + kstep, voffB);
        PG8_WAIT_V(6); PG8_BAR;
    }
    for (;;) {
        const bool has_next = S.next(ui + 1, nxt);
        const char* nA = has_next ? (const char*)g.A + (size_t)nxt.pm * tstep : cA; const char* nB = has_next ? (const char*)g.Bt + (size_t)nxt.pn * tstep : cB;
        for (int t = 0; t < nt; t += 2) {
            const bool last = (t == nt - 2);
            const char* a1 = cA + (size_t)(t + 1) * kstep;
            const char* a2 = last ? nA : cA + (size_t)(t + 2) * kstep; const char* b2 = last ? nB : cB + (size_t)(t + 2) * kstep;
            const char* a3 = a2 + kstep; const char* b3 = b2 + kstep;
            if (last && has_next) S.a_ready(nxt);
            if constexpr (SP2) {
            PG8_LDB(B0, 0, 0); PG8_LDB(B1, 0, 1); PG8_SCHED; PG8_LDA(At, 0, 0); PG8_STAGE(PG8_SA(1, 1), a1 + hstep, voffA);
            PG8_WAIT_V(8); PG8_WAIT_L(0); PG8_BAR; PG8_MMA(0, 0, At, B0); PG8_MMA(0, 1, At, B1); PG8_BAR; PG8_SCHED;
            PG8_LDA(At, 0, 1); PG8_STAGE(PG8_SB(0, 0), b2, voffB); PG8_STAGE(PG8_SB(0, 1), b2 + hstep, voffB); PG8_STAGE(PG8_SA(0, 0), a2, voffA);
            PG8_WAIT_V(8); PG8_WAIT_L(0); PG8_BAR; PG8_MMA(1, 0, At, B0); PG8_MMA(1, 1, At, B1); PG8_BAR; PG8_SCHED;
            PG8_LDB(B0, 1, 0); PG8_LDB(B1, 1, 1); PG8_SCHED; PG8_LDA(At, 1, 0); PG8_STAGE(PG8_SA(0, 1), a2 + hstep, voffA);
            PG8_WAIT_V(8); PG8_WAIT_L(0); PG8_BAR; PG8_MMA(0, 0, At, B0); PG8_MMA(0, 1, At, B1); PG8_BAR; PG8_SCHED;
            PG8_LDA(At, 1, 1); PG8_STAGE(PG8_SB(1, 0), b3, voffB); PG8_STAGE(PG8_SB(1, 1), b3 + hstep, voffB); PG8_STAGE(PG8_SA(1, 0), a3, voffA);
            PG8_WAIT_V(8); PG8_WAIT_L(0); PG8_BAR; PG8_MMA(1, 0, At, B0); PG8_MMA(1, 1, At, B1); PG8_BAR; PG8_SCHED;
            } else {
            PG8_LDB(B0, 0, 0); PG8_SCHED; PG8_LDA(At, 0, 0); PG8_STAGE(PG8_SA(1, 1), a1 + hstep, voffA);
            PG8_WAIT_L(8); PG8_BAR; PG8_WAIT_L(0); PG8_MMA(0, 0, At, B0); PG8_BAR; PG8_SCHED;
            PG8_LDB(B1, 0, 1); PG8_STAGE(PG8_SB(0, 0), b2, voffB);
            PG8_BAR; PG8_WAIT_L(0); PG8_MMA(0, 1, At, B1); PG8_BAR;
            PG8_LDA(At, 0, 1); PG8_STAGE(PG8_SA(0, 0), a2, voffA);
            PG8_BAR; PG8_WAIT_L(0); PG8_MMA(1, 0, At, B0); PG8_BAR; PG8_SCHED;
            PG8_STAGE(PG8_SB(0, 1), b2 + hstep, voffB);
            PG8_WAIT_V(6); PG8_BAR; PG8_MMA(1, 1, At, B1); PG8_BAR;
            PG8_LDB(B0, 1, 0); PG8_SCHED; PG8_LDA(At, 1, 0); PG8_STAGE(PG8_SA(0, 1), a2 + hstep, voffA);
            PG8_WAIT_L(8); PG8_BAR; PG8_WAIT_L(0); PG8_MMA(0, 0, At, B0); PG8_BAR; PG8_SCHED;
            PG8_LDB(B1, 1, 1); PG8_STAGE(PG8_SB(1, 0), b3, voffB);
            PG8_BAR; PG8_WAIT_L(0); PG8_MMA(0, 1, At, B1); PG8_BAR;
            PG8_LDA(At, 1, 1); PG8_STAGE(PG8_SA(1, 0), a3, voffA);
            PG8_BAR; PG8_WAIT_L(0); PG8_MMA(1, 0, At, B0); PG8_BAR; PG8_SCHED;
            PG8_STAGE(PG8_SB(1, 1), b3 + hstep, voffB);
            PG8_WAIT_V(6); PG8_BAR; PG8_MMA(1, 1, At, B1); PG8_BAR;
            }
        }
        if constexpr (ALIGN_EPI) { if (wr == 0) PG8_BAR; }
        if constexpr (!Epi::AFTER_DRAIN) { E(acc, cur, wr, wc, fr, fq); S.done(cur); }
        if (!has_next) break;
#pragma unroll
        for (int a = 0; a < 2; ++a)
#pragma unroll
            for (int b = 0; b < 2; ++b)
#pragma unroll
                for (int m = 0; m < 4; ++m)
#pragma unroll
                    for (int n = 0; n < 2; ++n) acc[a][b][m][n] = (f32x4){0.f, 0.f, 0.f, 0.f};
        cur = nxt; cA = nA; cB = nB; ++ui;
        if constexpr (ALIGN_EPI) { if (wr == 1) PG8_BAR; }
    }
    PG8_WAIT_V(0);
    if constexpr (!ALIGN_EPI) { if (wr == 0) PG8_BAR; }
    PG8_BAR;
    if constexpr (Epi::AFTER_DRAIN) { E.fused(acc, cur, wr, wc, fr, fq, lds, wid, lane); S.done(cur); }
#undef PG8_SA
#undef PG8_SB
#undef PG8_STAGE
#undef PG8_LDA
#undef PG8_LDB
#undef PG8_MMA
#undef PG8_WAIT_V
#undef PG8_WAIT_L
#undef PG8_BAR
#undef PG8_SCHED
}
}

constexpr int NWAVES = 8;
constexpr int D = 1024, NB = 8, TP = 2064, MP = NB * TP  , NS = 128, TS = 4, MS = NS * TS, MREAL = MP + MS  , MPAD = 17152  ;
constexpr int DEPTH = 4, HGW = 512, NPROJ = 4096, DFF = 2816, NAB = 2 * DFF, SEQP = 2048, NMETA = 16;
constexpr int NPOS = TP + TS;
constexpr float LN_EPS = 1e-5f, F_EPS = 1e-6f;
constexpr float ALPHA = 1.6817928305074290f;
constexpr float RT_KSCALE = 0.08838834764831845f;

constexpr size_t MiB = 1u << 20;
constexpr size_t WS_CTL = 0, CTL_ZERO_BYTES = 2 * MiB;
constexpr size_t CTL_STATS = 256 * 1024;
constexpr size_t CTL_GW = 1536 * 1024;
constexpr int GW_PER_LAYER = 2 * NPROJ + 2 * NAB;
static_assert(CTL_STATS + 9 * (size_t)MPAD * 8 <= CTL_GW && CTL_GW + (size_t)DEPTH * GW_PER_LAYER * 4 <= CTL_ZERO_BYTES, "ctl map");
constexpr size_t WS_SMALL = 2 * MiB;
constexpr size_t SM_LB = 0, SM_ONES = 8192, SM_ROPE = 16384;
static_assert(SM_ROPE + (size_t)NPOS * 64 * 8 <= 2 * MiB, "small map");
constexpr size_t WS_W = 4 * MiB;
constexpr size_t W_LAYER = (size_t)(NPROJ + D + NAB) * D * 2 + (size_t)D * DFF * 2;
constexpr size_t W_IN = 0, W_O = (size_t)NPROJ * D * 2, W_AB = W_O + (size_t)D * D * 2, W_DN = W_AB + (size_t)NAB * D * 2;
constexpr size_t WS_Y = 112 * MiB, WS_Y1 = 179 * MiB, WS_YB = 246 * MiB, WS_R = 280 * MiB;
static_assert(WS_W + DEPTH * W_LAYER <= WS_Y && (size_t)MPAD * D * 4 == 67 * MiB, "weights/y map");
constexpr size_t ACT = (size_t)MPAD * D * 2;
constexpr size_t R_QT = 0, R_KT = ACT, R_VR = 2 * ACT, R_GT = 3 * ACT, R_O = 4 * ACT, R_KTT = 5 * ACT, R_VTT = 6 * ACT, R_DEC = 7 * ACT, R_DECS = R_DEC + (size_t)(MPAD / 16) * HGW * 4;
constexpr size_t R_A = 0, R_G = (size_t)MPAD * DFF * 2;
constexpr size_t WS_END = WS_R + 240 * MiB;
static_assert(R_DECS + (size_t)NS * HGW * 4 <= 240 * MiB && R_G * 2 <= R_O + 0 * ACT + 240 * MiB, "region map");
static_assert(R_G * 2 <= 240 * MiB, "ffn overlay");

constexpr int CW_BAR = 4096;

constexpr int RING_BYTES = 131072, LDSCTL_OFF = RING_BYTES, MISC_OFF = LDSCTL_OFF + 320, LDS_BYTES = 147456;

#define GAS __attribute__((address_space(1)))
#define LAS __attribute__((address_space(3)))
typedef unsigned short bf16;
typedef unsigned v4u __attribute__((ext_vector_type(4)));
typedef unsigned v2u __attribute__((ext_vector_type(2)));
typedef float f32x4 __attribute__((ext_vector_type(4)));
typedef float f32x2 __attribute__((ext_vector_type(2)));
#define LDS_WAIT() asm volatile("s_waitcnt lgkmcnt(0)" ::: "memory")
#define VM_WAIT() asm volatile("s_waitcnt vmcnt(0)" ::: "memory")
__device__ __forceinline__ unsigned f2bf(float f) { unsigned u = __builtin_bit_cast(unsigned, f); return (u + 0x7fffu + ((u >> 16) & 1u)) >> 16; }
__device__ __forceinline__ float bf2f(unsigned h) { return __builtin_bit_cast(float, h << 16); }
__device__ __forceinline__ float bflo(unsigned w) { return __builtin_bit_cast(float, w << 16); }
__device__ __forceinline__ float bfhi(unsigned w) { return __builtin_bit_cast(float, w & 0xffff0000u); }
__device__ __forceinline__ unsigned pk2(float lo, float hi) { return pg8::cvt_pk_bf16(lo, hi); }
__device__ __forceinline__ float sigmoidf_(float x) { return 1.0f / (1.0f + __expf(-x)); }

#define XB_TMO      128
#define XB_XCNT(j)  (256  + 64 * (j))
#define XB_XSUB(j)  (1280 + 64 * (j))
#define XB_XGEN(j)  (2304 + 64 * (j))
#define XB_TOP      3328
#define XB_TOPGEN   3392
#define XCD_BAR_WORDS 3456
#define XB_SPIN_CAP (1u << 18)

__device__ __forceinline__ unsigned xb_ld(unsigned* p)              { return __hip_atomic_load(p, __ATOMIC_RELAXED, __HIP_MEMORY_SCOPE_AGENT); }
__device__ __forceinline__ unsigned xb_add(unsigned* p, unsigned v) { return __hip_atomic_fetch_add(p, v, __ATOMIC_RELAXED, __HIP_MEMORY_SCOPE_AGENT); }
__device__ __forceinline__ unsigned xb_xcc_id() { return (unsigned)__builtin_amdgcn_s_getreg((3 << 11) | 20) & 0xFu; }
#define XB_SPIN(cond, bar) do { unsigned _sp = 0; while (cond) { __builtin_amdgcn_s_sleep(1); \
    if ((++_sp & 255u) == 0u) { if (xb_ld(&(bar)[XB_TMO])) break; if (_sp > XB_SPIN_CAP) { atomicAdd(&(bar)[XB_TMO], 1u); break; } } } } while (0)

struct XcdBarrier {
    unsigned* bar; unsigned x;
    volatile LAS unsigned* st;
};

__device__ __forceinline__ XcdBarrier xcd_barrier_post(unsigned* bar, volatile LAS unsigned* st) {
    XcdBarrier b; b.bar = bar; b.x = xb_xcc_id(); b.st = st;
    if (threadIdx.x == 0) (void)xb_add(&bar[XB_XCNT(b.x)], 1u);
    return b;
}
__device__ __forceinline__ void xcd_barrier_complete(unsigned* bar, unsigned x, unsigned& nloc, unsigned& nx) {
    const unsigned G = gridDim.x * gridDim.y * gridDim.z;
    unsigned sum, cnt, mine, sp = 0u;
    for (;;) {
        sum = 0u; cnt = 0u; mine = 0u;
#pragma unroll
        for (unsigned j = 0; j < 16; ++j) { const unsigned c = xb_ld(&bar[XB_XCNT(j)]); sum += c; cnt += (c > 0u) ? 1u : 0u; mine = (j == x) ? c : mine; }
        if (sum == G) break;
        __builtin_amdgcn_s_sleep(1);
        if ((++sp & 255u) == 0u) { if (xb_ld(&bar[XB_TMO])) break; if (sp > XB_SPIN_CAP) { atomicAdd(&bar[XB_TMO], 1u); break; } }
    }
    nloc = mine > 0u ? mine : 1u; nx = cnt > 0u ? cnt : 1u;
}

__device__ __forceinline__ void xcd_barrier(const XcdBarrier& b) {
    asm volatile("s_waitcnt vmcnt(0)" ::: "memory");
    __syncthreads();
    if (threadIdx.x == 0) {
        unsigned* bar = b.bar;
        __builtin_amdgcn_s_waitcnt(0);
        unsigned nloc = b.st[0], nx = b.st[1];
        if (nloc == 0u) { xcd_barrier_complete(bar, b.x, nloc, nx); b.st[0] = nloc; b.st[1] = nx; }
        const unsigned old = xb_add(&bar[XB_XSUB(b.x)], 1u);
        const unsigned gen = old / nloc;
        if (old + 1u == (gen + 1u) * nloc) {
            __builtin_amdgcn_fence(__ATOMIC_RELEASE, "agent");
            asm volatile("s_waitcnt vmcnt(0)" ::: "memory");
            const unsigned og = xb_add(&bar[XB_TOP], 1u);
            const unsigned tg = og / nx;
            if (og + 1u == (tg + 1u) * nx) xb_add(&bar[XB_TOPGEN], 1u);
            else XB_SPIN(xb_ld(&bar[XB_TOPGEN]) == tg, bar);
            __builtin_amdgcn_fence(__ATOMIC_ACQUIRE, "agent");
            xb_add(&bar[XB_XGEN(b.x)], 1u);
            asm volatile("s_waitcnt vmcnt(0)" ::: "memory");
        } else {
            XB_SPIN(xb_ld(&bar[XB_XGEN(b.x)]) == gen, bar);
            __builtin_amdgcn_fence(__ATOMIC_ACQUIRE, "agent");
            asm volatile("s_waitcnt vmcnt(0)" ::: "memory");
        }
    }
    __syncthreads();
}


struct Frame {
    LAS unsigned char* lds;
    int tid, lane, wave;
    const float* const* in;
    float* out; unsigned char* ws;
};
enum { I_XP = 0, I_XS, I_SHG, I_SRT, I_SCV, I_META, I_EG, I_EB, I_LBL, I_WIN, I_HGN, I_GNG, I_GNB, I_WO, I_L1G, I_L1B, I_WA, I_WB, I_CW, I_CB, I_WD, I_L2G, I_L2B };
constexpr size_t O_YP = 0, O_YS = O_YP + (size_t)NB * SEQP * D, O_HP = O_YS + (size_t)NS * TS * D, O_HS = O_HP + (size_t)DEPTH * NB * 4 * 16384,
                 O_RP = O_HS + (size_t)DEPTH * NS * 4 * 16384, O_RS = O_RP + (size_t)DEPTH * NB * 4 * 16384, O_CP = O_RS + (size_t)DEPTH * NS * 4 * 16384,
                 O_CS = O_CP + (size_t)DEPTH * NB * 2 * DFF, O_END = O_CS + (size_t)DEPTH * NS * 2 * DFF;
static_assert(O_END == 91668480, "output size");

__device__ __forceinline__ f32x2* stats_ptr(unsigned char* ws, int idx) { return (f32x2*)(ws + WS_CTL + CTL_STATS) + (size_t)idx * MPAD; }
__device__ __forceinline__ float* gw_ptr(unsigned char* ws, int l, int which) {
    float* p = (float*)(ws + WS_CTL + CTL_GW) + (size_t)l * GW_PER_LAYER;
    return which == 0 ? p : which == 1 ? p + NPROJ : which == 2 ? p + 2 * NPROJ : p + 2 * NPROJ + NAB;
}
__device__ __forceinline__ bf16* w_ptr(unsigned char* ws, int l, size_t off) { return (bf16*)(ws + WS_W + (size_t)l * W_LAYER + off); }

__device__ __forceinline__ float wave_sum(float v) {
#pragma unroll
    for (int o = 1; o < 64; o <<= 1) v += __shfl_xor(v, o);
    return v;
}

__device__ __forceinline__ int win_src_col(int np) {
    const int tile = np >> 8, j = np & 255, bj = j >> 7, jj = j & 127;
    if (tile < 4) return bj == 0 ? 128 * tile + jj : 512 + 128 * tile + jj;
    if (tile < 6) return 1024 + 256 * (tile - 4) + j;
    if (tile < 8) return 1536 + 256 * (tile - 6) + j;
    if (tile < 12) { const int base = tile < 10 ? 2048 : 2560, hd = 2 * (tile & 1) + (jj >> 6), i = jj & 63; return base + 128 * hd + 64 * bj + i; }
    if (tile < 14) return 3072 + 256 * (tile - 12) + j;
    return 3584 + 256 * (tile - 14) + j;
}
__device__ __forceinline__ void tr_item(const float* W, int Nsrc, int scol, const float* gv, const float* bv, bf16* WT, int K, int n0, float* gW, float* bW, LAS float* scr, int k0, int lane) {
    float bacc = 0.f;
#pragma unroll 8
    for (int i = 0; i < 32; ++i) { const int kk = 2 * i + (lane >> 5); float w = W[(size_t)(k0 + kk) * Nsrc + scol];
        if (gv) { bacc += w * bv[k0 + kk]; w *= gv[k0 + kk]; }
        scr[kk * 33 + (lane & 31)] = w; }
    LDS_WAIT(); asm volatile("" ::: "memory");
    const int c = lane & 7;
#pragma unroll
    for (int j = 0; j < 4; ++j) { const int n = (lane >> 3) + 8 * j; const LAS float* s = scr + (8 * c) * 33 + n;
        unsigned h[8]; float gs = 0.f;
#pragma unroll
        for (int e = 0; e < 8; ++e) { h[e] = f2bf(s[e * 33]); gs += bf2f(h[e]); }
        v4u o; o.x = h[0] | (h[1] << 16); o.y = h[2] | (h[3] << 16); o.z = h[4] | (h[5] << 16); o.w = h[6] | (h[7] << 16);
        *(v4u*)(WT + (size_t)(n0 + n) * K + k0 + 8 * c) = o;
        if (gv) { gs += __shfl_xor(gs, 1); gs += __shfl_xor(gs, 2); gs += __shfl_xor(gs, 4); if (c == 0) atomicAdd(gW + n0 + n, gs); } }
    if (gv) { bacc += __shfl_xor(bacc, 32); if (lane < 32) atomicAdd(bW + n0 + lane, bacc); }
    LDS_WAIT(); asm volatile("" ::: "memory");
}
__device__ __forceinline__ void p0_prologue(Frame& F) {
    unsigned char* ws = F.ws;
    LAS float* scr = (LAS float*)(F.lds + F.wave * 16384);
    const int gw = blockIdx.x * NWAVES + F.wave, NGW = gridDim.x * NWAVES, lane = F.lane;
    const int gtid = blockIdx.x * (NWAVES * 64) + F.tid, NT = gridDim.x * NWAVES * 64;
    constexpr int I_IN = 16 * 128, I_O = 16 * 32, I_AB = 16 * 176, I_D = 44 * 32, I_L = I_IN + I_O + I_AB + I_D;
    for (int it = gw; it < DEPTH * I_L; it += NGW) {
        const int l = it / I_L; int r = it - l * I_L;
        if (r < I_IN) { const int kb = r / 128, nb = r % 128, n0 = 32 * nb;
            const float* gv = l ? F.in[I_L2G] + (l - 1) * D : nullptr; const float* bv = l ? F.in[I_L2B] + (l - 1) * D : nullptr;
            tr_item(F.in[I_WIN] + (size_t)l * D * NPROJ, NPROJ, win_src_col(n0 + (lane & 31)), gv, bv, w_ptr(ws, l, W_IN), D, n0, gw_ptr(ws, l, 0), gw_ptr(ws, l, 1), scr, 64 * kb, lane); continue; }
        r -= I_IN;
        if (r < I_O) { const int kb = r / 32, nb = r % 32, n0 = 32 * nb;
            tr_item(F.in[I_WO] + (size_t)l * D * D, D, n0 + (lane & 31), nullptr, nullptr, w_ptr(ws, l, W_O), D, n0, nullptr, nullptr, scr, 64 * kb, lane); continue; }
        r -= I_O;
        if (r < I_AB) { const int kb = r / 176, nb = r % 176, n0 = 32 * nb, tile = n0 >> 8, bj = (n0 >> 7) & 1, jj = (n0 & 127) + (lane & 31);
            const float* W = (bj ? F.in[I_WB] : F.in[I_WA]) + (size_t)l * D * DFF;
            tr_item(W, DFF, 128 * tile + jj, F.in[I_L1G] + l * D, F.in[I_L1B] + l * D, w_ptr(ws, l, W_AB), D, n0, gw_ptr(ws, l, 2), gw_ptr(ws, l, 3), scr, 64 * kb, lane); continue; }
        r -= I_AB;
        { const int kb = r / 32, nb = r % 32, n0 = 32 * nb;
            tr_item(F.in[I_WD] + (size_t)l * DFF * D, D, n0 + (lane & 31), nullptr, nullptr, w_ptr(ws, l, W_DN), DFF, n0, nullptr, nullptr, scr, 64 * kb, lane); }
    }
    float* lb = (float*)(ws + WS_SMALL + SM_LB);
    if (gtid < HGW) { const float* L = F.in[I_LBL]; const float a0 = L[gtid], a1 = L[HGW + gtid], a2 = L[2 * HGW + gtid], a3 = L[3 * HGW + gtid];
        const float mx = fmaxf(fmaxf(a0, a1), fmaxf(a2, a3)); const float e0 = expf(a0 - mx), e1 = expf(a1 - mx), e2 = expf(a2 - mx), e3 = expf(a3 - mx), inv = 1.0f / (e0 + e1 + e2 + e3);
        lb[gtid] = 0.f; lb[HGW + gtid] = e1 * inv; lb[2 * HGW + gtid] = (e1 + e2) * inv; lb[3 * HGW + gtid] = (e1 + e2 + e3) * inv; }
    if (gtid >= 1024 && gtid < 2048) ((float*)(ws + WS_SMALL + SM_ONES))[gtid - 1024] = 1.0f;
    { f32x2* st = stats_ptr(ws, 0); for (int r = gtid; r < MPAD; r += NT) st[r] = (f32x2){0.f, 1024.0f * (1.0f - LN_EPS)}; }
    { f32x2* rope = (f32x2*)(ws + WS_SMALL + SM_ROPE);
      for (int e = gtid; e < NPOS * 64; e += NT) { const int pi = e >> 6, i = e & 63; const int pos = pi < TP ? pi : 16384 + (pi - TP);
          const float inv = (float)pow(10000.0, -(double)i / 64.0); const float ang = (float)pos * inv;
          rope[e] = (f32x2){(float)cos((double)ang), (float)sin((double)ang)}; } }
    float* Y = (float*)(ws + WS_Y); bf16* YB = (bf16*)(ws + WS_YB);
    const float* eg = F.in[I_EG]; const float* eb = F.in[I_EB];
    for (int row = gw; row < MPAD; row += NGW) {
        f32x4* yo = (f32x4*)(Y + (size_t)row * D) + lane; v2u* bo = (v2u*)(YB + (size_t)row * D) + lane;
        if (row >= MREAL) {
#pragma unroll
            for (int j = 0; j < 4; ++j) { yo[64 * j] = (f32x4){0.f, 0.f, 0.f, 0.f}; bo[64 * j] = (v2u){0u, 0u}; }
            continue; }
        const float* src;
        if (row < MP) { const int b = row / TP, t = row - b * TP; src = t < NMETA ? F.in[I_META] + (size_t)t * D : F.in[I_XP] + ((size_t)b * SEQP + (t - NMETA)) * D; }
        else src = F.in[I_XS] + (size_t)(row - MP) * D;
        const f32x4* xr = (const f32x4*)src + lane;
        f32x4 v[4]; float s = 0.f;
#pragma unroll
        for (int j = 0; j < 4; ++j) { v[j] = xr[64 * j]; s += (v[j].x + v[j].y) + (v[j].z + v[j].w); }
        const float mean = wave_sum(s) * (1.f / D); float s2 = 0.f;
#pragma unroll
        for (int j = 0; j < 4; ++j) { v[j] = v[j] - mean; s2 += (v[j].x * v[j].x + v[j].y * v[j].y) + (v[j].z * v[j].z + v[j].w * v[j].w); }
        const float rstd = 1.f / sqrtf(wave_sum(s2) * (1.f / D) + LN_EPS);
#pragma unroll
        for (int j = 0; j < 4; ++j) { const f32x4 g = ((const f32x4*)eg)[lane + 64 * j], b = ((const f32x4*)eb)[lane + 64 * j]; const f32x4 y = v[j] * rstd * g + b;
            yo[64 * j] = y; bo[64 * j] = (v2u){pk2(y.x, y.y), pk2(y.z, y.w)}; }
    }
}

using pg8::Unit;
struct EpiIn {
    static constexpr bool PERM = true, AFTER_DRAIN = false;
    const f32x2* st; const float* gW; const float* bW; const float* lb; const f32x2* rope;
    bf16* QT; bf16* KT; bf16* VR; bf16* GT; float* DEC; float* DECS;
    template <int TYPE>
    __device__ __forceinline__ void run(const f32x4 (&acc)[2][2][4][2], const Unit& u, int wr, int wc, int fr, int fq) const {
        const int pn = u.pn, jj0 = wc * 32 + 8 * fq;
        f32x4 lbv[2] = {(f32x4){0.f, 0.f, 0.f, 0.f}, (f32x4){0.f, 0.f, 0.f, 0.f}};
        if (TYPE == 0) { lbv[0] = *(const f32x4*)(lb + 128 * pn + jj0); lbv[1] = *(const f32x4*)(lb + 128 * pn + jj0 + 4); }
        const int hd = 2 * (pn & 1) + (jj0 >> 6), i0 = jj0 & 63;
        const float lg = log1pf(-exp2f(-5.0f - (float)hd));
        const int cb12 = ((pn & 8) ? 512 : 0) + 256 * (pn & 1);
#pragma unroll
        for (int ai = 0; ai < 2; ++ai) {
            const int rowbase = u.pm * 256 + ai * 128 + wr * 64;
            const bool smp = rowbase >= MP;
            const int tau = smp ? (fr & 3) : fr;
#pragma unroll
            for (int m = 0; m < 4; ++m) {
                const int row = rowbase + 16 * m + fr;
                const f32x2 s = st[row]; const float mu = s.x * (1.f / D), rstd = rsqrtf(s.y * (1.f / D) - mu * mu + LN_EPS);
                f32x4 v[2][2];
#pragma unroll
                for (int bj = 0; bj < 2; ++bj)
#pragma unroll
                    for (int n = 0; n < 2; ++n) { const f32x4 gwv = *(const f32x4*)(gW + 256 * pn + 128 * bj + jj0 + 4 * n), bwv = *(const f32x4*)(bW + 256 * pn + 128 * bj + jj0 + 4 * n);
                        v[bj][n] = (acc[ai][bj][m][n] - mu * gwv) * rstd + bwv; }
                if (TYPE == 0) {
                    float qt[8], kt[8], bb[8];
#pragma unroll
                    for (int n = 0; n < 2; ++n)
#pragma unroll
                        for (int i = 0; i < 4; ++i) { const float hq = v[0][n][i], hf = v[1][n][i], l0 = lbv[n][i];
                            const float sg = sigmoidf_(hf), f = l0 + (1.f - l0) * sg; float b = __logf(fmaxf(f, F_EPS));
                            const float kk = (1.f - l0) * (1.f - sg), q = hq * sigmoidf_(hq);
                            { float y = __shfl_up(b, 1, 16); if (tau >= 1) b += y; y = __shfl_up(b, 2, 16); if (tau >= 2) b += y;
                              if (!smp) { y = __shfl_up(b, 4, 16); if (tau >= 4) b += y; y = __shfl_up(b, 8, 16); if (tau >= 8) b += y; } }
                            bb[4 * n + i] = b; qt[4 * n + i] = q * __expf(b); kt[4 * n + i] = kk * __expf(-b); }
                    const size_t o = (size_t)row * D + 128 * pn + jj0;
                    *(v4u*)(QT + o) = (v4u){pk2(qt[0], qt[1]), pk2(qt[2], qt[3]), pk2(qt[4], qt[5]), pk2(qt[6], qt[7])};
                    *(v4u*)(KT + o) = (v4u){pk2(kt[0], kt[1]), pk2(kt[2], kt[3]), pk2(kt[4], kt[5]), pk2(kt[6], kt[7])};
                    if (!smp) { if (fr == 15) { float* d = DEC + (size_t)(row >> 4) * HGW + 128 * pn + jj0; *(f32x4*)d = (f32x4){bb[0], bb[1], bb[2], bb[3]}; *(f32x4*)(d + 4) = (f32x4){bb[4], bb[5], bb[6], bb[7]}; } }
                    else if ((fr & 3) == 3) { float* d = DECS + (size_t)((row - MP) >> 2) * HGW + 128 * pn + jj0; *(f32x4*)d = (f32x4){bb[0], bb[1], bb[2], bb[3]}; *(f32x4*)(d + 4) = (f32x4){bb[4], bb[5], bb[6], bb[7]}; }
                } else if (TYPE == 1 || TYPE == 2) {
                    bf16* dst = (TYPE == 1 ? VR : GT) + (size_t)row * D + cb12 + jj0;
#pragma unroll
                    for (int bj = 0; bj < 2; ++bj) { f32x4 a = v[bj][0], b = v[bj][1];
                        if (TYPE == 2) {
#pragma unroll
                            for (int i = 0; i < 4; ++i) { a[i] = a[i] * sigmoidf_(a[i]); b[i] = b[i] * sigmoidf_(b[i]); } }
                        *(v4u*)(dst + 128 * bj) = (v4u){pk2(a[0], a[1]), pk2(a[2], a[3]), pk2(b[0], b[1]), pk2(b[2], b[3])}; }
                } else {
                    const int pi = smp ? TP + ((row - MP) & 3) : row - TP * (row / TP);
                    const f32x4* cs = (const f32x4*)(rope + (size_t)pi * 64 + i0);
                    const float sc = TYPE == 3 ? __expf((float)(tau + 1) * lg) : RT_KSCALE * __expf(-(float)(tau + 1) * lg);
                    float o1[8], o2[8];
#pragma unroll
                    for (int p = 0; p < 4; ++p) { const f32x4 c2 = cs[p];
#pragma unroll
                        for (int e = 0; e < 2; ++e) { const int j = 2 * p + e; const float c = c2[2 * e], sn = c2[2 * e + 1], x1 = v[0][j >> 2][j & 3], x2 = v[1][j >> 2][j & 3];
                            o1[j] = (x1 * c - x2 * sn) * sc; o2[j] = (x1 * sn + x2 * c) * sc; } }
                    bf16* dst = (TYPE == 3 ? QT : KT) + (size_t)row * D + HGW + 128 * hd + i0;
                    *(v4u*)dst = (v4u){pk2(o1[0], o1[1]), pk2(o1[2], o1[3]), pk2(o1[4], o1[5]), pk2(o1[6], o1[7])};
                    *(v4u*)(dst + 64) = (v4u){pk2(o2[0], o2[1]), pk2(o2[2], o2[3]), pk2(o2[4], o2[5]), pk2(o2[6], o2[7])};
                }
                asm volatile("" ::: "memory");
            }
        }
    }
    __device__ __forceinline__ void operator()(const f32x4 (&acc)[2][2][4][2], const Unit& u, int wr, int wc, int fr, int fq) const {
        const int pn = u.pn;
        if (pn < 4) run<0>(acc, u, wr, wc, fr, fq);
        else if (pn == 4 || pn == 5 || pn == 12 || pn == 13) run<1>(acc, u, wr, wc, fr, fq);
        else if (pn == 6 || pn == 7 || pn >= 14) run<2>(acc, u, wr, wc, fr, fq);
        else if (pn < 10) run<3>(acc, u, wr, wc, fr, fq);
        else run<4>(acc, u, wr, wc, fr, fq);
    }
};
struct EpiRes {
    static constexpr bool PERM = false, AFTER_DRAIN = false;
    const float* Yin; float* Yout; bf16* YB; const f32x2* st_in; const float* g; const float* b; f32x2* st_out;
    __device__ __forceinline__ void operator()(const f32x4 (&acc)[2][2][4][2], const Unit& u, int wr, int wc, int fr, int fq) const {
        const int col0 = u.pn * 256 + wc * 32 + 4 * fq;
        f32x4 gv[2][2], bv[2][2];
#pragma unroll
        for (int bj = 0; bj < 2; ++bj)
#pragma unroll
            for (int n = 0; n < 2; ++n) { gv[bj][n] = *(const f32x4*)(g + col0 + 128 * bj + 16 * n); bv[bj][n] = *(const f32x4*)(b + col0 + 128 * bj + 16 * n); }
#pragma unroll
        for (int ai = 0; ai < 2; ++ai)
#pragma unroll
            for (int m = 0; m < 4; ++m) {
                const int row = u.pm * 256 + ai * 128 + wr * 64 + 16 * m + fr;
                const f32x2 s = st_in[row]; const float mu = s.x * (1.f / D), rstd = rsqrtf(s.y * (1.f / D) - mu * mu + LN_EPS);
                const size_t off = (size_t)row * D + col0; float sy = 0.f, sq = 0.f;
#pragma unroll
                for (int bj = 0; bj < 2; ++bj)
#pragma unroll
                    for (int n = 0; n < 2; ++n) { const f32x4 yi = *(const f32x4*)(Yin + off + 128 * bj + 16 * n);
                        const f32x4 x = (yi - mu) * rstd * gv[bj][n] + bv[bj][n]; const f32x4 y = ALPHA * x + acc[ai][bj][m][n];
                        *(f32x4*)(Yout + off + 128 * bj + 16 * n) = y; *(v2u*)(YB + off + 128 * bj + 16 * n) = (v2u){pk2(y[0], y[1]), pk2(y[2], y[3])};
                        sy += (y[0] + y[1]) + (y[2] + y[3]); sq += (y[0] * y[0] + y[1] * y[1]) + (y[2] * y[2] + y[3] * y[3]); }
                sy += __shfl_xor(sy, 16); sy += __shfl_xor(sy, 32); sq += __shfl_xor(sq, 16); sq += __shfl_xor(sq, 32);
                if (fq == 0) { float* so = (float*)(st_out + row); atomicAdd(so, sy); atomicAdd(so + 1, sq); }
                if (m & 1) asm volatile("" ::: "memory");
            }
    }
};
struct EpiUp {
    static constexpr bool PERM = true, AFTER_DRAIN = false;
    const f32x2* st; const float* gW; const float* bW; bf16* A; bf16* G;
    __device__ __forceinline__ void operator()(const f32x4 (&acc)[2][2][4][2], const Unit& u, int wr, int wc, int fr, int fq) const {
        const int pn = u.pn, jj0 = wc * 32 + 8 * fq;
        f32x4 gw[2][2], bw[2][2];
#pragma unroll
        for (int bj = 0; bj < 2; ++bj)
#pragma unroll
            for (int n = 0; n < 2; ++n) { gw[bj][n] = *(const f32x4*)(gW + 256 * pn + 128 * bj + jj0 + 4 * n); bw[bj][n] = *(const f32x4*)(bW + 256 * pn + 128 * bj + jj0 + 4 * n); }
#pragma unroll
        for (int ai = 0; ai < 2; ++ai)
#pragma unroll
            for (int m = 0; m < 4; ++m) {
                const int row = u.pm * 256 + ai * 128 + wr * 64 + 16 * m + fr;
                const f32x2 s = st[row]; const float mu = s.x * (1.f / D), rstd = rsqrtf(s.y * (1.f / D) - mu * mu + LN_EPS);
                const size_t o = (size_t)row * DFF + 128 * pn + jj0;
#pragma unroll
                for (int bj = 0; bj < 2; ++bj) { const f32x4 a = (acc[ai][bj][m][0] - mu * gw[bj][0]) * rstd + bw[bj][0], b = (acc[ai][bj][m][1] - mu * gw[bj][1]) * rstd + bw[bj][1];
                    *(v4u*)((bj ? G : A) + o) = (v4u){pk2(a[0], a[1]), pk2(a[2], a[3]), pk2(b[0], b[1]), pk2(b[2], b[3])}; }
            }
    }
};

__device__ __forceinline__ void mixer_naive(Frame& F, int l) {
    unsigned char* ws = F.ws;
    const int tid = F.tid, v = tid & 127, kq = tid >> 7;
    LAS unsigned char* L = F.lds;
    LAS bf16* TL = (LAS bf16*)L;
    LAS float* Es = (LAS float*)(L + 16384);
    LAS float* OP = (LAS float*)(L + 16384 + 512);
    const bf16* QT = (const bf16*)(ws + WS_R + R_QT); const bf16* KT = (const bf16*)(ws + WS_R + R_KT); const bf16* VR = (const bf16*)(ws + WS_R + R_VR); const bf16* GT = (const bf16*)(ws + WS_R + R_GT);
    bf16* O = (bf16*)(ws + WS_R + R_O);
    const float* DEC = (const float*)(ws + WS_R + R_DEC); const float* DECS = (const float*)(ws + WS_R + R_DECS);
    const int w = blockIdx.x;
    for (int it = 0;; ++it) {
        bool smp; int seq, H, nchunks, ntok, row_base;
        if (w < 64) { if (it > 0) break; smp = false; seq = w >> 3; H = w & 7; nchunks = TP / 16; ntok = 16; row_base = seq * TP; }
        else { const int id = (w - 64) + (int)(gridDim.x - 64) * it; if (id >= NS * 8) break; smp = true; seq = id >> 3; H = id & 7; nchunks = 1; ntok = 4; row_base = MP + 4 * seq; }
        const bool hg = H < 4; const int h = H & 3;
        float Z[32];
        if (smp) { const float* S0 = (hg ? F.in[I_SHG] : F.in[I_SRT]) + (((size_t)l * NS + seq) * 4 + h) * 16384;
#pragma unroll
            for (int j = 0; j < 32; ++j) Z[j] = S0[(kq * 32 + j) * 128 + v]; }
        else {
#pragma unroll
            for (int j = 0; j < 32; ++j) Z[j] = 0.f; }
        const float lg = log1pf(-exp2f(-5.0f - (float)h)), Eret = __expf(lg * (float)ntok);
        const float* nrm_g = hg ? F.in[I_HGN] + l * HGW + 128 * h : F.in[I_GNG] + l * HGW + 128 * h;
        const float* nrm_b = F.in[I_GNB] + l * HGW + 128 * h;
        for (int c = 0; c < nchunks; ++c) {
            const int row0 = row_base + 16 * c;
            { const int tile = tid >> 7, p = tid & 127; const bf16* src = tile == 0 ? QT : tile == 1 ? KT : tile == 2 ? VR : GT;
#pragma unroll
              for (int rr = 0; rr < 2; ++rr) { const int r = (p >> 4) + 8 * rr; v4u x = (v4u){0u, 0u, 0u, 0u};
                  if (r < ntok) x = *(const v4u*)(src + (size_t)(row0 + r) * D + 128 * H + (p & 15) * 8);
                  *(LAS v4u*)(TL + tile * 2048 + r * 128 + (p & 15) * 8) = x; } }
            if (tid < 128) Es[tid] = hg ? __expf(smp ? DECS[(size_t)seq * HGW + 128 * h + tid] : DEC[(size_t)(row0 >> 4) * HGW + 128 * h + tid]) : Eret;
            __syncthreads();
            for (int t = 0; t < ntok; ++t) {
                const float vv = bf2f(TL[2 * 2048 + t * 128 + v]);
                float op = 0.f;
#pragma unroll
                for (int j4 = 0; j4 < 4; ++j4) { const v4u kw = *(const LAS v4u*)(TL + 2048 + t * 128 + kq * 32 + 8 * j4), qw = *(const LAS v4u*)(TL + t * 128 + kq * 32 + 8 * j4);
#pragma unroll
                    for (int e = 0; e < 4; ++e) { const unsigned ku = kw[e], qu = qw[e];
                        Z[8 * j4 + 2 * e] = fmaf(bflo(ku), vv, Z[8 * j4 + 2 * e]); op = fmaf(Z[8 * j4 + 2 * e], bflo(qu), op);
                        Z[8 * j4 + 2 * e + 1] = fmaf(bfhi(ku), vv, Z[8 * j4 + 2 * e + 1]); op = fmaf(Z[8 * j4 + 2 * e + 1], bfhi(qu), op); } }
                OP[(t * 4 + kq) * 128 + v] = op;
            }
            __syncthreads();
            { const int tt = tid >> 5, v4 = (tid & 31) * 4;
              f32x4 o = (f32x4){0.f, 0.f, 0.f, 0.f};
              if (tt < ntok) {
#pragma unroll
                  for (int q = 0; q < 4; ++q) o += *(const LAS f32x4*)(OP + (tt * 4 + q) * 128 + v4); }
              float s = (o[0] + o[1]) + (o[2] + o[3]), ss = (o[0] * o[0] + o[1] * o[1]) + (o[2] * o[2] + o[3] * o[3]);
#pragma unroll
              for (int x = 1; x < 32; x <<= 1) { s += __shfl_xor(s, x); ss += __shfl_xor(ss, x); }
              const v2u gwd = *(const LAS v2u*)(TL + 3 * 2048 + tt * 128 + v4);
              const float gt[4] = {bflo(gwd.x), bfhi(gwd.x), bflo(gwd.y), bfhi(gwd.y)};
              const f32x4 ng = *(const f32x4*)(nrm_g + v4);
              float r[4];
              if (hg) { const float rs = rsqrtf(ss * (1.f / 128.f) + LN_EPS);
#pragma unroll
                  for (int i = 0; i < 4; ++i) r[i] = o[i] * rs * ng[i] * gt[i]; }
              else { const f32x4 nb = *(const f32x4*)(nrm_b + v4); const float mean = s * (1.f / 128.f), rs = rsqrtf(ss * (1.f / 128.f) - mean * mean + LN_EPS);
#pragma unroll
                  for (int i = 0; i < 4; ++i) r[i] = ((o[i] - mean) * rs * ng[i] + nb[i]) * gt[i]; }
              if (tt < ntok) *(v2u*)(O + (size_t)(row0 + tt) * D + 128 * H + v4) = (v2u){pk2(r[0], r[1]), pk2(r[2], r[3])}; }
#pragma unroll
            for (int j = 0; j < 32; ++j) Z[j] *= Es[kq * 32 + j];
            __syncthreads();
        }
        float* dst = F.out + (smp ? (hg ? O_HS : O_RS) + (((size_t)l * NS + seq) * 4 + h) * 16384 : (hg ? O_HP : O_RP) + (((size_t)l * NB + seq) * 4 + h) * 16384);
#pragma unroll
        for (int j = 0; j < 32; ++j) dst[(kq * 32 + j) * 128 + v] = Z[j];
    }
}

__device__ __forceinline__ void unpack8(const v4u w, float (&f)[8]) {
#pragma unroll
    for (int e = 0; e < 4; ++e) { f[2 * e] = bflo(w[e]); f[2 * e + 1] = bfhi(w[e]); }
}
__device__ __forceinline__ float gelu_tanh(float x) { const float u = 0.7978845608028654f * (x + 0.044715f * x * x * x); return x / (1.0f + __expf(-2.0f * u)); }
__device__ __forceinline__ void conv_phase(Frame& F, int l) {
    unsigned char* ws = F.ws;
    const bf16* A = (const bf16*)(ws + WS_R + R_A); bf16* G = (bf16*)(ws + WS_R + R_G);
    const float* cw = F.in[I_CW] + (size_t)l * 3 * DFF; const float* cb = F.in[I_CB] + (size_t)l * DFF;
    const float* scv = F.in[I_SCV] + (size_t)l * NS * 2 * DFF;
    float* ocp = F.out + O_CP + (size_t)l * NB * 2 * DFF; float* ocs = F.out + O_CS + (size_t)l * NS * 2 * DFF;
    constexpr int FG = DFF / 8  , NRC = MPAD / 16  ;
    const int gtid = blockIdx.x * (NWAVES * 64) + F.tid, NT = gridDim.x * NWAVES * 64;
    for (int item = gtid; item < NRC * FG; item += NT) {
        const int rc = item / FG, fg = item - rc * FG, f0 = fg * 8, row0 = rc * 16;
        if (row0 >= MREAL) { for (int r = 0; r < 16; ++r) *(v4u*)(G + (size_t)(row0 + r) * DFF + f0) = (v4u){0u, 0u, 0u, 0u}; continue; }
        float w0[8], w1[8], w2[8], bb[8];
#pragma unroll
        for (int e = 0; e < 8; ++e) { w0[e] = cw[f0 + e]; w1[e] = cw[DFF + f0 + e]; w2[e] = cw[2 * DFF + f0 + e]; bb[e] = cb[f0 + e]; }
        const bool smp = row0 >= MP;
        float a1[8], a2[8];
        const int tseq = smp ? 0 : row0 - TP * (row0 / TP);
        if (!smp && tseq > 0) { unpack8(*(const v4u*)(A + (size_t)(row0 - 1) * DFF + f0), a1); unpack8(*(const v4u*)(A + (size_t)(row0 - 2) * DFF + f0), a2); }
        else {
#pragma unroll
            for (int e = 0; e < 8; ++e) { a1[e] = 0.f; a2[e] = 0.f; } }
        for (int r = 0; r < 16; ++r) {
            const int row = row0 + r;
            if (smp && (r & 3) == 0) { const int s = (row - MP) >> 2;
#pragma unroll
                for (int e = 0; e < 8; ++e) { a2[e] = scv[((size_t)s * 2 + 0) * DFF + f0 + e]; a1[e] = scv[((size_t)s * 2 + 1) * DFF + f0 + e]; } }
            float a0[8], g[8], hh[8];
            unpack8(*(const v4u*)(A + (size_t)row * DFF + f0), a0); unpack8(*(const v4u*)(G + (size_t)row * DFF + f0), g);
#pragma unroll
            for (int e = 0; e < 8; ++e) { const float cv = bb[e] + w0[e] * a2[e] + w1[e] * a1[e] + w2[e] * a0[e]; hh[e] = gelu_tanh(cv) * g[e]; }
            *(v4u*)(G + (size_t)row * DFF + f0) = (v4u){pk2(hh[0], hh[1]), pk2(hh[2], hh[3]), pk2(hh[4], hh[5]), pk2(hh[6], hh[7])};
            if (!smp) { const int t = tseq + r; if (t >= TP - 2) { float* d = ocp + ((size_t)(row0 / TP) * 2 + (t - (TP - 2))) * DFF + f0;
#pragma unroll
                    for (int e = 0; e < 8; ++e) d[e] = a0[e]; } }
            else if ((r & 3) >= 2) { float* d = ocs + ((size_t)((row - MP) >> 2) * 2 + ((r & 3) - 2)) * DFF + f0;
#pragma unroll
                for (int e = 0; e < 8; ++e) d[e] = a0[e]; }
#pragma unroll
            for (int e = 0; e < 8; ++e) { a2[e] = a1[e]; a1[e] = a0[e]; }
        }
    }
}

__device__ __forceinline__ void final_phase(Frame& F) {
    unsigned char* ws = F.ws;
    const float* Y = (const float*)(ws + WS_Y); const f32x2* st = stats_ptr(ws, 4);
    const float* g = F.in[I_L2G] + 3 * D; const float* b = F.in[I_L2B] + 3 * D;
    const int gw = blockIdx.x * NWAVES + F.wave, NGW = gridDim.x * NWAVES, lane = F.lane;
    for (int row = gw; row < MREAL; row += NGW) {
        float* dst;
        if (row < MP) { const int bb = row / TP, t = row - bb * TP; if (t < NMETA) continue; dst = F.out + O_YP + ((size_t)bb * SEQP + (t - NMETA)) * D; }
        else dst = F.out + O_YS + (size_t)(row - MP) * D;
        const f32x2 s = st[row]; const float mu = s.x * (1.f / D), rstd = rsqrtf(s.y * (1.f / D) - mu * mu + LN_EPS);
#pragma unroll
        for (int j = 0; j < 4; ++j) { const f32x4 y = ((const f32x4*)(Y + (size_t)row * D))[lane + 64 * j]; const f32x4 gg = ((const f32x4*)g)[lane + 64 * j], bb = ((const f32x4*)b)[lane + 64 * j];
            ((f32x4*)dst)[lane + 64 * j] = (y - mu) * rstd * gg + bb; }
    }
}

#ifndef ONE_LAUNCH
#define ONE_LAUNCH 0
#endif
constexpr int NPHASES = 2 + 6 * DEPTH;
struct Args { const float* in[23]; float* out; unsigned char* ws; int ph_lo, ph_hi; };
template <int ONLY_SUB> __global__ void __launch_bounds__(NWAVES * 64, 2) hymba_fwd(Args args) {
    extern __shared__ __attribute__((aligned(16))) unsigned char lds[];
    Frame F;
    F.lds = (LAS unsigned char*)lds;
    F.tid = threadIdx.x; F.lane = F.tid & 63; F.wave = __builtin_amdgcn_readfirstlane(F.tid >> 6);
    F.in = args.in; F.out = args.out; F.ws = args.ws;
    for (int u = F.tid; u < (LDS_BYTES - LDSCTL_OFF) / 4; u += NWAVES * 64) ((LAS unsigned*)(F.lds + LDSCTL_OFF))[u] = 0u;
    __syncthreads();
#if ONE_LAUNCH
    XcdBarrier bar = xcd_barrier_post((unsigned*)(args.ws + WS_CTL) + CW_BAR, (volatile LAS unsigned*)(F.lds + MISC_OFF) + 8);
#define SEAM() xcd_barrier(bar)
#else
#define SEAM() do {} while (0)
#endif
    const int lo = args.ph_lo, hi = args.ph_hi;
    const int G = gridDim.x, cid = blockIdx.x;
#define SUBON(x) (ONLY_SUB < 0 || ONLY_SUB == (x))
    for (int ph = lo; ph < hi; ++ph) {
        { int t_ = threadIdx.x; asm volatile("" : "+v"(t_)); F.tid = t_; F.lane = t_ & 63; F.wave = __builtin_amdgcn_readfirstlane(t_ >> 6);
          unsigned long long w_ = (unsigned long long)args.ws, o_ = (unsigned long long)args.out; asm volatile("" : "+s"(w_), "+s"(o_));
          F.ws = (unsigned char*)w_; F.out = (float*)o_; }
        unsigned char* ws = F.ws;
        if (ph == 0) { if (SUBON(10)) p0_prologue(F); }
        else if (ph == NPHASES - 1) { if (SUBON(11)) final_phase(F); }
        else {
            const int l = (ph - 1) / 6, sub = (ph - 1) % 6;
            if (sub == 0 && SUBON(0)) {
                pg8::Gemm g{(const bf16*)(ws + WS_YB), w_ptr(ws, l, W_IN), MPAD, NPROJ, D}; pg8::StaticOrder S; S.init(MPAD, NPROJ, G, cid);
                EpiIn E{stats_ptr(ws, l), gw_ptr(ws, l, 0), gw_ptr(ws, l, 1), (const float*)(ws + WS_SMALL + SM_LB) + l * HGW, (const f32x2*)(ws + WS_SMALL + SM_ROPE),
                        (bf16*)(ws + WS_R + R_QT), (bf16*)(ws + WS_R + R_KT), (bf16*)(ws + WS_R + R_VR), (bf16*)(ws + WS_R + R_GT), (float*)(ws + WS_R + R_DEC), (float*)(ws + WS_R + R_DECS)};
                pg8::gemm_phase<EpiIn, pg8::StaticOrder, true, true>(F.lds, g, S, E);
            } else if (sub == 1 && SUBON(1)) {
                mixer_naive(F, l);
            } else if (sub == 2 && SUBON(2)) {
                pg8::Gemm g{(const bf16*)(ws + WS_R + R_O), w_ptr(ws, l, W_O), MPAD, D, D}; pg8::StaticOrder S; S.init(MPAD, D, G, cid);
                const float* lg = l ? F.in[I_L2G] + (l - 1) * D : (const float*)(ws + WS_SMALL + SM_ONES);
                const float* lb = l ? F.in[I_L2B] + (l - 1) * D : (const float*)(ws + WS_CTL + 1024);
                EpiRes E{(const float*)(ws + WS_Y), (float*)(ws + WS_Y1), (bf16*)(ws + WS_YB), stats_ptr(ws, l), lg, lb, stats_ptr(ws, 5 + l)};
                pg8::gemm_phase<EpiRes, pg8::StaticOrder, true, true>(F.lds, g, S, E);
            } else if (sub == 3 && SUBON(3)) {
                pg8::Gemm g{(const bf16*)(ws + WS_YB), w_ptr(ws, l, W_AB), MPAD, NAB, D}; pg8::StaticOrder S; S.init(MPAD, NAB, G, cid);
                EpiUp E{stats_ptr(ws, 5 + l), gw_ptr(ws, l, 2), gw_ptr(ws, l, 3), (bf16*)(ws + WS_R + R_A), (bf16*)(ws + WS_R + R_G)};
                pg8::gemm_phase<EpiUp, pg8::StaticOrder, true, true>(F.lds, g, S, E);
            } else if (sub == 4 && SUBON(4)) {
                conv_phase(F, l);
            } else if (SUBON(5)) {
                pg8::Gemm g{(const bf16*)(ws + WS_R + R_G), w_ptr(ws, l, W_DN), MPAD, D, DFF}; pg8::StaticOrder S; S.init(MPAD, D, G, cid);
                EpiRes E{(const float*)(ws + WS_Y1), (float*)(ws + WS_Y), (bf16*)(ws + WS_YB), stats_ptr(ws, 5 + l), F.in[I_L1G] + l * D, F.in[I_L1B] + l * D, stats_ptr(ws, l + 1)};
                pg8::gemm_phase<EpiRes, pg8::StaticOrder, true, true>(F.lds, g, S, E);
            }
        }
        if (ph + 1 < hi) SEAM();
    }
}

extern "C" void kernel_launch(void* const* d_in, const int* in_sizes, int n_in, void* d_out, int out_size, void* d_ws, size_t ws_size, hipStream_t stream) {
    static int grid = 0;
    if (grid == 0) {
        if (n_in != 23 || out_size != (int)O_END || ws_size < WS_END) { fprintf(stderr, "kernel_launch: unexpected shapes: n_in %d out %d ws %zu (need %zu)\n", n_in, out_size, ws_size, (size_t)WS_END); grid = -1; return; }
        int dev = 0, cus = 0;
        if (hipGetDevice(&dev) != hipSuccess || hipDeviceGetAttribute(&cus, hipDeviceAttributeMultiprocessorCount, dev) != hipSuccess) { grid = -1; return; }
        bool ok = true;
#if ONE_LAUNCH
        ok = ok && hipFuncSetAttribute((const void*)hymba_fwd<-1>, hipFuncAttributeMaxDynamicSharedMemorySize, LDS_BYTES) == hipSuccess;
#else
        ok = ok && hipFuncSetAttribute((const void*)hymba_fwd<0>, hipFuncAttributeMaxDynamicSharedMemorySize, LDS_BYTES) == hipSuccess;
        ok = ok && hipFuncSetAttribute((const void*)hymba_fwd<1>, hipFuncAttributeMaxDynamicSharedMemorySize, LDS_BYTES) == hipSuccess;
        ok = ok && hipFuncSetAttribute((const void*)hymba_fwd<2>, hipFuncAttributeMaxDynamicSharedMemorySize, LDS_BYTES) == hipSuccess;
        ok = ok && hipFuncSetAttribute((const void*)hymba_fwd<3>, hipFuncAttributeMaxDynamicSharedMemorySize, LDS_BYTES) == hipSuccess;
        ok = ok && hipFuncSetAttribute((const void*)hymba_fwd<4>, hipFuncAttributeMaxDynamicSharedMemorySize, LDS_BYTES) == hipSuccess;
        ok = ok && hipFuncSetAttribute((const void*)hymba_fwd<5>, hipFuncAttributeMaxDynamicSharedMemorySize, LDS_BYTES) == hipSuccess;
        ok = ok && hipFuncSetAttribute((const void*)hymba_fwd<10>, hipFuncAttributeMaxDynamicSharedMemorySize, LDS_BYTES) == hipSuccess;
        ok = ok && hipFuncSetAttribute((const void*)hymba_fwd<11>, hipFuncAttributeMaxDynamicSharedMemorySize, LDS_BYTES) == hipSuccess;
#endif
        if (!ok) { fprintf(stderr, "kernel_launch: hipFuncSetAttribute failed\n"); grid = -1; return; }
        (void)hipGetLastError();
        grid = cus;
    }
    if (grid < 0) return;
    (void)hipMemsetAsync((char*)d_ws + WS_CTL, 0, CTL_ZERO_BYTES, stream);
    Args a{};
    for (int i = 0; i < 23; ++i) a.in[i] = (const float*)d_in[i];
    a.out = (float*)d_out; a.ws = (unsigned char*)d_ws;
#if ONE_LAUNCH
    a.ph_lo = 0; a.ph_hi = NPHASES;
    hipLaunchKernelGGL(hymba_fwd<-1>, dim3(grid), dim3(NWAVES * 64), LDS_BYTES, stream, a);
#else
    for (int p = 0; p < NPHASES; ++p) { a.ph_lo = p; a.ph_hi = p + 1;
        const int sub = p == 0 ? 10 : p == NPHASES - 1 ? 11 : (p - 1) % 6;
        switch (sub) {
            case 0: hipLaunchKernelGGL(hymba_fwd<0>, dim3(grid), dim3(NWAVES * 64), LDS_BYTES, stream, a); break;
            case 1: hipLaunchKernelGGL(hymba_fwd<1>, dim3(grid), dim3(NWAVES * 64), LDS_BYTES, stream, a); break;
            case 2: hipLaunchKernelGGL(hymba_fwd<2>, dim3(grid), dim3(NWAVES * 64), LDS_BYTES, stream, a); break;
            case 3: hipLaunchKernelGGL(hymba_fwd<3>, dim3(grid), dim3(NWAVES * 64), LDS_BYTES, stream, a); break;
            case 4: hipLaunchKernelGGL(hymba_fwd<4>, dim3(grid), dim3(NWAVES * 64), LDS_BYTES, stream, a); break;
            case 5: hipLaunchKernelGGL(hymba_fwd<5>, dim3(grid), dim3(NWAVES * 64), LDS_BYTES, stream, a); break;
            case 10: hipLaunchKernelGGL(hymba_fwd<10>, dim3(grid), dim3(NWAVES * 64), LDS_BYTES, stream, a); break;
            default: hipLaunchKernelGGL(hymba_fwd<11>, dim3(grid), dim3(NWAVES * 64), LDS_BYTES, stream, a); break;
        }
    }
#endif
}
```

```cpp
#include <hip/hip_runtime.h>
#include <cstdio>
#include <cstdint>
namespace pg8 {
#define PG8_LAS __attribute__((address_space(3)))
typedef unsigned short bf16_t;
typedef short bf16x8 __attribute__((ext_vector_type(8)));
typedef float f32x4 __attribute__((ext_vector_type(4)));
typedef unsigned u32x4 __attribute__((ext_vector_type(4)));
constexpr int BM = 256, BK = 64, HALF = 128, HTB = HALF * BK * 2  , STAGE_BYTES = 8 * HTB, NXCD = 8, WGM = 8;

__host__ __device__ __forceinline__ int lds_byte(int r, int c) { const int st = (r >> 4) * 2 + (c >> 5), rr = r & 15, cc = c & 31, ob = rr * 64 + cc * 2; return st * 1024 + (ob ^ (((ob >> 9) & 1) << 5)); }
__host__ __device__ __forceinline__ void stage_rc(int b, int& R, int& C) { const int st = b / 1024, sb = b % 1024, swz = sb ^ (((sb >> 9) & 1) << 5); R = (st >> 1) * 16 + swz / 64; C = (st & 1) * 32 + (swz % 64) / 2; }
__host__ __device__ __forceinline__ int perm32(int rho) { const int n = rho >> 4, i = rho & 15; return 8 * (i >> 2) + 4 * n + (i & 3); }

struct Unit { int pm, pn; };
struct Gemm { const bf16_t* A; const bf16_t* Bt; int M, N, K; };

struct StaticOrder {
    int nM, nN, nwg, G, c;
    __host__ __device__ void init(int M, int N, int G_, int c_) { nM = M / BM; nN = N / BM; nwg = nM * nN; G = G_; c = c_; }
    __host__ __device__ bool next(int i, Unit& u) const {
        const long L = (long)i * G + c; if (L >= nwg) return false;
        int wgid = (int)L; { const int q = nwg / NXCD, r = nwg % NXCD, xcd = wgid % NXCD, off = wgid / NXCD; wgid = (xcd < r ? xcd * (q + 1) : r * (q + 1) + (xcd - r) * q) + off; }
        const int nig = WGM * nN, gid = wgid / nig, fm = gid * WGM, gsz = (nM - fm) < WGM ? (nM - fm) : WGM;
        u.pm = fm + ((wgid % nig) % gsz); u.pn = (wgid % nig) / gsz; return true;
    }
    __device__ __forceinline__ void a_ready(const Unit&) const {}
    __device__ __forceinline__ void done(const Unit&) const {}
};

__device__ __forceinline__ unsigned cvt_pk_bf16(float lo, float hi) { unsigned r; asm volatile("v_cvt_pk_bf16_f32 %0, %1, %2" : "=v"(r) : "v"(lo), "v"(hi)); return r; }
template <class Epi, class Sched, bool ALIGN_EPI = false, bool SP2 = false>
__device__ __forceinline__ void gemm_phase(PG8_LAS unsigned char* lds, const Gemm g, const Sched& S, const Epi& E) {
    int tid_ = threadIdx.x; asm volatile("" : "+v"(tid_));
    const int tid = tid_, wid = __builtin_amdgcn_readfirstlane(tid >> 6), lane = tid & 63, wr = wid >> 2, wc = wid & 3, fr = lane & 15, fq = lane >> 4;
    const int K = g.K, nt = K / BK;
    unsigned voffA[2], voffB[2];
#pragma unroll
    for (int i = 0; i < 2; ++i) { int R, C; stage_rc(tid * 16 + i * 8192, R, C); const int Rb = Epi::PERM ? ((R & ~31) + perm32(R & 31)) : R;
        voffA[i] = (unsigned)(R * K + C) * 2u; voffB[i] = (unsigned)(Rb * K + C) * 2u; }
    const size_t kstep = (size_t)(BK * 2);
    const size_t hstep = (size_t)HALF * K * 2;
    const size_t tstep = 2 * hstep;
    const unsigned ldsw = (unsigned)wid * 1024u;
    const int aoff = lds_byte(wr * 64 + fr, fq * 8), boff = lds_byte(wc * 32 + fr, fq * 8);
#define PG8_SA(b, h) (((b) * 2 + (h)) * HTB)
#define PG8_SB(b, h) ((4 + (b) * 2 + (h)) * HTB)
#define PG8_STAGE(bufoff, gbase, voff) do { _Pragma("unroll") for (int _i = 0; _i < 2; ++_i) \
        __builtin_amdgcn_global_load_lds((const unsigned*)((const char*)(gbase) + (voff)[_i]), (PG8_LAS unsigned*)(lds + (bufoff) + ldsw + _i * 8192), 16, 0, 0); } while (0)
#define PG8_LDA(dst, b, h) do { _Pragma("unroll") for (int m = 0; m < 4; ++m) _Pragma("unroll") for (int k = 0; k < 2; ++k) dst[m][k] = *(const PG8_LAS bf16x8*)(lds + PG8_SA(b, h) + aoff + m * 2048 + k * 1024); } while (0)
#define PG8_LDB(dst, b, h) do { _Pragma("unroll") for (int n = 0; n < 2; ++n) _Pragma("unroll") for (int k = 0; k < 2; ++k) dst[n][k] = *(const PG8_LAS bf16x8*)(lds + PG8_SB(b, h) + boff + n * 2048 + k * 1024); } while (0)
#define PG8_MMA(ai, bj, At, Bt) do { __builtin_amdgcn_s_setprio(1); _Pragma("unroll") for (int m = 0; m < 4; ++m) _Pragma("unroll") for (int n = 0; n < 2; ++n) _Pragma("unroll") for (int k = 0; k < 2; ++k) \
        acc[ai][bj][m][n] = __builtin_amdgcn_mfma_f32_16x16x32_bf16(Bt[n][k], At[m][k], acc[ai][bj][m][n], 0, 0, 0); __builtin_amdgcn_s_setprio(0); } while (0)
#define PG8_WAIT_V(n) asm volatile("s_waitcnt vmcnt(" #n ")" ::: "memory")
#define PG8_WAIT_L(n) asm volatile("s_waitcnt lgkmcnt(" #n ")" ::: "memory")
#define PG8_BAR __builtin_amdgcn_s_barrier()
#define PG8_SCHED __builtin_amdgcn_sched_barrier(0)
    Unit cur, nxt; int ui = 0;
    if (!S.next(0, cur)) return;
    f32x4 acc[2][2][4][2];
#pragma unroll
    for (int a = 0; a < 2; ++a)
#pragma unroll
        for (int b = 0; b < 2; ++b)
#pragma unroll
            for (int m = 0; m < 4; ++m)
#pragma unroll
                for (int n = 0; n < 2; ++n) acc[a][b][m][n] = (f32x4){0.f, 0.f, 0.f, 0.f};
    bf16x8 At[4][2], B0[2][2], B1[2][2];
    const char* cA = (const char*)g.A + (size_t)cur.pm * tstep; const char* cB = (const char*)g.Bt + (size_t)cur.pn * tstep;
    S.a_ready(cur);
    if constexpr (SP2) {
        PG8_STAGE(PG8_SB(0, 0), cB, voffB); PG8_STAGE(PG8_SB(0, 1), cB + hstep, voffB); PG8_STAGE(PG8_SA(0, 0), cA, voffA); PG8_STAGE(PG8_SA(0, 1), cA + hstep, voffA);
        if (wr == 1) PG8_BAR;
        PG8_WAIT_V(2); PG8_BAR;
        PG8_STAGE(PG8_SB(1, 0), cB + kstep, voffB); PG8_STAGE(PG8_SA(1, 0), cA + kstep, voffA); PG8_STAGE(PG8_SB(1, 1), cB + hstep + kstep, voffB);
        PG8_WAIT_V(6); PG8_BAR;
    } else {
        PG8_STAGE(PG8_SB(0, 0), cB, voffB); PG8_STAGE(PG8_SA(0, 0), cA, voffA); PG8_STAGE(PG8_SB(0, 1), cB + hstep, voffB); PG8_STAGE(PG8_SA(0, 1), cA + hstep, voffA);
        if (wr == 1) PG8_BAR;
        PG8_WAIT_V(4); PG8_BAR;
        PG8_STAGE(PG8_SB(1, 0), cB + kstep, voffB); PG8_STAGE(PG8_SA(1, 0), cA + kstep, voffA); PG8_STAGE(PG8_SB(1, 1), cB + hstep + kstep, voffB);
        PG8_WAIT_V(6); PG8_BAR;
    }
    for (;;) {
        const bool has_next = S.next(ui + 1, nxt);
        const char* nA = has_next ? (const char*)g.A + (size_t)nxt.pm * tstep : cA; const char* nB = has_next ? (const char*)g.Bt + (size_t)nxt.pn * tstep : cB;
        for (int t = 0; t < nt; t += 2) {
            const bool last = (t == nt - 2);
            const char* a1 = cA + (size_t)(t + 1) * kstep;
            const char* a2 = last ? nA : cA + (size_t)(t + 2) * kstep; const char* b2 = last ? nB : cB + (size_t)(t + 2) * kstep;
            const char* a3 = a2 + kstep; const char* b3 = b2 + kstep;
            if (last && has_next) S.a_ready(nxt);
            if constexpr (SP2) {
            PG8_LDB(B0, 0, 0); PG8_LDB(B1, 0, 1); PG8_SCHED; PG8_LDA(At, 0, 0); PG8_STAGE(PG8_SA(1, 1), a1 + hstep, voffA);
            PG8_WAIT_V(8); PG8_WAIT_L(0); PG8_BAR; PG8_MMA(0, 0, At, B0); PG8_MMA(0, 1, At, B1); PG8_BAR; PG8_SCHED;
            PG8_LDA(At, 0, 1); PG8_STAGE(PG8_SB(0, 0), b2, voffB); PG8_STAGE(PG8_SB(0, 1), b2 + hstep, voffB); PG8_STAGE(PG8_SA(0, 0), a2, voffA);
            PG8_WAIT_V(8); PG8_WAIT_L(0); PG8_BAR; PG8_MMA(1, 0, At, B0); PG8_MMA(1, 1, At, B1); PG8_BAR; PG8_SCHED;
            PG8_LDB(B0, 1, 0); PG8_LDB(B1, 1, 1); PG8_SCHED; PG8_LDA(At, 1, 0); PG8_STAGE(PG8_SA(0, 1), a2 + hstep, voffA);
            PG8_WAIT_V(8); PG8_WAIT_L(0); PG8_BAR; PG8_MMA(0, 0, At, B0); PG8_MMA(0, 1, At, B1); PG8_BAR; PG8_SCHED;
            PG8_LDA(At, 1, 1); PG8_STAGE(PG8_SB(1, 0), b3, voffB); PG8_STAGE(PG8_SB(1, 1), b3 + hstep, voffB); PG8_STAGE(PG8_SA(1, 0), a3, voffA);
            PG8_WAIT_V(8); PG8_WAIT_L(0); PG8_BAR; PG8_MMA(1, 0, At, B0); PG8_MMA(1, 1, At, B1); PG8_BAR; PG8_SCHED;
            } else {
            PG8_LDB(B0, 0, 0); PG8_SCHED; PG8_LDA(At, 0, 0); PG8_STAGE(PG8_SA(1, 1), a1 + hstep, voffA);
            PG8_WAIT_L(8); PG8_BAR; PG8_WAIT_L(0); PG8_MMA(0, 0, At, B0); PG8_BAR; PG8_SCHED;
            PG8_LDB(B1, 0, 1); PG8_STAGE(PG8_SB(0, 0), b2, voffB);
            PG8_BAR; PG8_WAIT_L(0); PG8_MMA(0, 1, At, B1); PG8_BAR;
            PG8_LDA(At, 0, 1); PG8_STAGE(PG8_SA(0, 0), a2, voffA);
            PG8_BAR; PG8_WAIT_L(0); PG8_MMA(1, 0, At, B0); PG8_BAR; PG8_SCHED;
            PG8_STAGE(PG8_SB(0, 1), b2 + hstep, voffB);
            PG8_WAIT_V(6); PG8_BAR; PG8_MMA(1, 1, At, B1); PG8_BAR;
            PG8_LDB(B0, 1, 0); PG8_SCHED; PG8_LDA(At, 1, 0); PG8_STAGE(PG8_SA(0, 1), a2 + hstep, voffA);
            PG8_WAIT_L(8); PG8_BAR; PG8_WAIT_L(0); PG8_MMA(0, 0, At, B0); PG8_BAR; PG8_SCHED;
            PG8_LDB(B1, 1, 1); PG8_STAGE(PG8_SB(1, 0), b3, voffB);
            PG8_BAR; PG8_WAIT_L(0); PG8_MMA(0, 1, At, B1); PG8_BAR;
            PG8_LDA(At, 1, 1); PG8_STAGE(PG8_SA(1, 0), a3, voffA);
            PG8_BAR; PG8_WAIT_L(0); PG8_MMA(1, 0, At, B0); PG8_BAR; PG8_SCHED;
            PG8_STAGE(PG8_SB(1, 1), b3 + hstep, voffB);
            PG8_WAIT_V(6); PG8_BAR; PG8_MMA(1, 1, At, B1); PG8_BAR;
            }
        }
        if constexpr (ALIGN_EPI) { if (wr == 0) PG8_BAR; }
        if constexpr (!Epi::AFTER_DRAIN) { E(acc, cur, wr, wc, fr, fq); S.done(cur); }
        if (!has_next) break;
#pragma unroll
        for (int a = 0; a < 2; ++a)
#pragma unroll
            for (int b = 0; b < 2; ++b)
#pragma unroll
                for (int m = 0; m < 4; ++m)
#pragma unroll
                    for (int n = 0; n < 2; ++n) acc[a][b][m][n] = (f32x4){0.f, 0.f, 0.f, 0.f};
        cur = nxt; cA = nA; cB = nB; ++ui;
        if constexpr (ALIGN_EPI) { if (wr == 1) PG8_BAR; }
    }
    PG8_WAIT_V(0);
    if constexpr (!ALIGN_EPI) { if (wr == 0) PG8_BAR; }
    PG8_BAR;
    if constexpr (Epi::AFTER_DRAIN) { E.fused(acc, cur, wr, wc, fr, fq, lds, wid, lane); S.done(cur); }
#undef PG8_SA
#undef PG8_SB
#undef PG8_STAGE
#undef PG8_LDA
#undef PG8_LDB
#undef PG8_MMA
#undef PG8_WAIT_V
#undef PG8_WAIT_L
#undef PG8_BAR
#undef PG8_SCHED
}
}

constexpr int NWAVES = 8;
constexpr int D = 1024, NB = 8, TP = 2064, MP = NB * TP  , NS = 128, TS = 4, MS = NS * TS, MREAL = MP + MS  , MPAD = 17152  ;
constexpr int DEPTH = 4, HGW = 512, NPROJ = 4096, DFF = 2816, NAB = 2 * DFF, SEQP = 2048, NMETA = 16;
constexpr int NPOS = TP + TS;
constexpr float LN_EPS = 1e-5f, F_EPS = 1e-6f;
constexpr float ALPHA = 1.6817928305074290f;
constexpr float RT_KSCALE = 0.08838834764831845f;

constexpr size_t MiB = 1u << 20;
constexpr size_t WS_CTL = 0, CTL_ZERO_BYTES = 2 * MiB;
constexpr size_t CTL_STATS = 256 * 1024;
constexpr size_t CTL_GW = 1536 * 1024;
constexpr int GW_PER_LAYER = 2 * NPROJ + 2 * NAB;
static_assert(CTL_STATS + 9 * (size_t)MPAD * 8 <= CTL_GW && CTL_GW + (size_t)DEPTH * GW_PER_LAYER * 4 <= CTL_ZERO_BYTES, "ctl map");
constexpr size_t WS_SMALL = 2 * MiB;
constexpr size_t SM_LB = 0, SM_ONES = 8192, SM_ROPE = 16384;
static_assert(SM_ROPE + (size_t)NPOS * 64 * 8 <= 2 * MiB, "small map");
constexpr size_t WS_W = 4 * MiB;
constexpr size_t W_LAYER = (size_t)(NPROJ + D + NAB) * D * 2 + (size_t)D * DFF * 2;
constexpr size_t W_IN = 0, W_O = (size_t)NPROJ * D * 2, W_AB = W_O + (size_t)D * D * 2, W_DN = W_AB + (size_t)NAB * D * 2;
constexpr size_t WS_Y = 112 * MiB, WS_Y1 = 179 * MiB, WS_YB = 246 * MiB, WS_R = 280 * MiB;
static_assert(WS_W + DEPTH * W_LAYER <= WS_Y && (size_t)MPAD * D * 4 == 67 * MiB, "weights/y map");
constexpr size_t ACT = (size_t)MPAD * D * 2;
constexpr size_t R_QT = 0, R_KT = ACT, R_VR = 2 * ACT, R_GT = 3 * ACT, R_O = 4 * ACT, R_KTT = 5 * ACT, R_VTT = 6 * ACT, R_DEC = 7 * ACT, R_DECS = R_DEC + (size_t)(MPAD / 16) * HGW * 4;
constexpr size_t R_A = 0, R_G = (size_t)MPAD * DFF * 2;
constexpr size_t WS_END = WS_R + 240 * MiB;
static_assert(R_DECS + (size_t)NS * HGW * 4 <= 240 * MiB && R_G * 2 <= R_O + 0 * ACT + 240 * MiB, "region map");
static_assert(R_G * 2 <= 240 * MiB, "ffn overlay");

constexpr int CW_BAR = 4096;

constexpr int RING_BYTES = 131072, LDSCTL_OFF = RING_BYTES, MISC_OFF = LDSCTL_OFF + 320, LDS_BYTES = 147456;

#define GAS __attribute__((address_space(1)))
#define LAS __attribute__((address_space(3)))
typedef unsigned short bf16;
typedef unsigned v4u __attribute__((ext_vector_type(4)));
typedef unsigned v2u __attribute__((ext_vector_type(2)));
typedef float f32x4 __attribute__((ext_vector_type(4)));
typedef float f32x2 __attribute__((ext_vector_type(2)));
#define LDS_WAIT() asm volatile("s_waitcnt lgkmcnt(0)" ::: "memory")
#define VM_WAIT() asm volatile("s_waitcnt vmcnt(0)" ::: "memory")
__device__ __forceinline__ unsigned f2bf(float f) { unsigned u = __builtin_bit_cast(unsigned, f); return (u + 0x7fffu + ((u >> 16) & 1u)) >> 16; }
__device__ __forceinline__ float bf2f(unsigned h) { return __builtin_bit_cast(float, h << 16); }
__device__ __forceinline__ float bflo(unsigned w) { return __builtin_bit_cast(float, w << 16); }
__device__ __forceinline__ float bfhi(unsigned w) { return __builtin_bit_cast(float, w & 0xffff0000u); }
__device__ __forceinline__ unsigned pk2(float lo, float hi) { return pg8::cvt_pk_bf16(lo, hi); }
__device__ __forceinline__ float sigmoidf_(float x) { return 1.0f / (1.0f + __expf(-x)); }

#define XB_TMO      128
#define XB_XCNT(j)  (256  + 64 * (j))
#define XB_XSUB(j)  (1280 + 64 * (j))
#define XB_XGEN(j)  (2304 + 64 * (j))
#define XB_TOP      3328
#define XB_TOPGEN   3392
#define XCD_BAR_WORDS 3456
#define XB_SPIN_CAP (1u << 18)

__device__ __forceinline__ unsigned xb_ld(unsigned* p)              { return __hip_atomic_load(p, __ATOMIC_RELAXED, __HIP_MEMORY_SCOPE_AGENT); }
__device__ __forceinline__ unsigned xb_add(unsigned* p, unsigned v) { return __hip_atomic_fetch_add(p, v, __ATOMIC_RELAXED, __HIP_MEMORY_SCOPE_AGENT); }
__device__ __forceinline__ unsigned xb_xcc_id() { return (unsigned)__builtin_amdgcn_s_getreg((3 << 11) | 20) & 0xFu; }
#define XB_SPIN(cond, bar) do { unsigned _sp = 0; while (cond) { __builtin_amdgcn_s_sleep(1); \
    if ((++_sp & 255u) == 0u) { if (xb_ld(&(bar)[XB_TMO])) break; if (_sp > XB_SPIN_CAP) { atomicAdd(&(bar)[XB_TMO], 1u); break; } } } } while (0)

struct XcdBarrier {
    unsigned* bar; unsigned x;
    volatile LAS unsigned* st;
};

__device__ __forceinline__ XcdBarrier xcd_barrier_post(unsigned* bar, volatile LAS unsigned* st) {
    XcdBarrier b; b.bar = bar; b.x = xb_xcc_id(); b.st = st;
    if (threadIdx.x == 0) (void)xb_add(&bar[XB_XCNT(b.x)], 1u);
    return b;
}
__device__ __forceinline__ void xcd_barrier_complete(unsigned* bar, unsigned x, unsigned& nloc, unsigned& nx) {
    const unsigned G = gridDim.x * gridDim.y * gridDim.z;
    unsigned sum, cnt, mine, sp = 0u;
    for (;;) {
        sum = 0u; cnt = 0u; mine = 0u;
#pragma unroll
        for (unsigned j = 0; j < 16; ++j) { const unsigned c = xb_ld(&bar[XB_XCNT(j)]); sum += c; cnt += (c > 0u) ? 1u : 0u; mine = (j == x) ? c : mine; }
        if (sum == G) break;
        __builtin_amdgcn_s_sleep(1);
        if ((++sp & 255u) == 0u) { if (xb_ld(&bar[XB_TMO])) break; if (sp > XB_SPIN_CAP) { atomicAdd(&bar[XB_TMO], 1u); break; } }
    }
    nloc = mine > 0u ? mine : 1u; nx = cnt > 0u ? cnt : 1u;
}

__device__ __forceinline__ void xcd_barrier(const XcdBarrier& b) {
    asm volatile("s_waitcnt vmcnt(0)" ::: "memory");
    __syncthreads();
    if (threadIdx.x == 0) {
        unsigned* bar = b.bar;
        __builtin_amdgcn_s_waitcnt(0);
        unsigned nloc = b.st[0], nx = b.st[1];
        if (nloc == 0u) { xcd_barrier_complete(bar, b.x, nloc, nx); b.st[0] = nloc; b.st[1] = nx; }
        const unsigned old = xb_add(&bar[XB_XSUB(b.x)], 1u);
        const unsigned gen = old / nloc;
        if (old + 1u == (gen + 1u) * nloc) {
            __builtin_amdgcn_fence(__ATOMIC_RELEASE, "agent");
            asm volatile("s_waitcnt vmcnt(0)" ::: "memory");
            const unsigned og = xb_add(&bar[XB_TOP], 1u);
            const unsigned tg = og / nx;
            if (og + 1u == (tg + 1u) * nx) xb_add(&bar[XB_TOPGEN], 1u);
            else XB_SPIN(xb_ld(&bar[XB_TOPGEN]) == tg, bar);
            __builtin_amdgcn_fence(__ATOMIC_ACQUIRE, "agent");
            xb_add(&bar[XB_XGEN(b.x)], 1u);
            asm volatile("s_waitcnt vmcnt(0)" ::: "memory");
        } else {
            XB_SPIN(xb_ld(&bar[XB_XGEN(b.x)]) == gen, bar);
            __builtin_amdgcn_fence(__ATOMIC_ACQUIRE, "agent");
            asm volatile("s_waitcnt vmcnt(0)" ::: "memory");
        }
    }
    __syncthreads();
}


struct Frame {
    LAS unsigned char* lds;
    int tid, lane, wave;
    const float* const* in;
    float* out; unsigned char* ws;
};
enum { I_XP = 0, I_XS, I_SHG, I_SRT, I_SCV, I_META, I_EG, I_EB, I_LBL, I_WIN, I_HGN, I_GNG, I_GNB, I_WO, I_L1G, I_L1B, I_WA, I_WB, I_CW, I_CB, I_WD, I_L2G, I_L2B };
constexpr size_t O_YP = 0, O_YS = O_YP + (size_t)NB * SEQP * D, O_HP = O_YS + (size_t)NS * TS * D, O_HS = O_HP + (size_t)DEPTH * NB * 4 * 16384,
                 O_RP = O_HS + (size_t)DEPTH * NS * 4 * 16384, O_RS = O_RP + (size_t)DEPTH * NB * 4 * 16384, O_CP = O_RS + (size_t)DEPTH * NS * 4 * 16384,
                 O_CS = O_CP + (size_t)DEPTH * NB * 2 * DFF, O_END = O_CS + (size_t)DEPTH * NS * 2 * DFF;
static_assert(O_END == 91668480, "output size");

__device__ __forceinline__ f32x2* stats_ptr(unsigned char* ws, int idx) { return (f32x2*)(ws + WS_CTL + CTL_STATS) + (size_t)idx * MPAD; }
__device__ __forceinline__ float* gw_ptr(unsigned char* ws, int l, int which) {
    float* p = (float*)(ws + WS_CTL + CTL_GW) + (size_t)l * GW_PER_LAYER;
    return which == 0 ? p : which == 1 ? p + NPROJ : which == 2 ? p + 2 * NPROJ : p + 2 * NPROJ + NAB;
}
__device__ __forceinline__ bf16* w_ptr(unsigned char* ws, int l, size_t off) { return (bf16*)(ws + WS_W + (size_t)l * W_LAYER + off); }

__device__ __forceinline__ float wave_sum(float v) {
#pragma unroll
    for (int o = 1; o < 64; o <<= 1) v += __shfl_xor(v, o);
    return v;
}

__device__ __forceinline__ int win_src_col(int np) {
    const int tile = np >> 8, j = np & 255, bj = j >> 7, jj = j & 127;
    if (tile < 4) return bj == 0 ? 128 * tile + jj : 512 + 128 * tile + jj;
    if (tile < 6) return 1024 + 256 * (tile - 4) + j;
    if (tile < 8) return 1536 + 256 * (tile - 6) + j;
    if (tile < 12) { const int base = tile < 10 ? 2048 : 2560, hd = 2 * (tile & 1) + (jj >> 6), i = jj & 63; return base + 128 * hd + 64 * bj + i; }
    if (tile < 14) return 3072 + 256 * (tile - 12) + j;
    return 3584 + 256 * (tile - 14) + j;
}
__device__ __forceinline__ float rope_inv(int i) {
    static const float T[64] = {1.0f, 0.865964353f, 0.749894202f, 0.649381638f, 0.562341332f, 0.486967534f, 0.421696514f, 0.365174115f, 0.316227764f, 0.273841977f, 0.237137377f, 0.2053525f, 0.177827939f, 0.153992653f, 0.133352146f, 0.115478195f, 0.100000001f, 0.0865964293f, 0.0749894232f, 0.0649381652f, 0.0562341325f, 0.0486967526f, 0.0421696492f, 0.0365174115f, 0.0316227749f, 0.0273841955f, 0.0237137377f, 0.0205352511f, 0.0177827943f, 0.0153992651f, 0.013335214f, 0.0115478197f, 0.00999999978f, 0.00865964312f, 0.00749894232f, 0.00649381615f, 0.00562341325f, 0.00486967526f, 0.00421696482f, 0.00365174119f, 0.00316227763f, 0.00273841969f, 0.00237137382f, 0.00205352507f, 0.00177827943f, 0.00153992651f, 0.00133352145f, 0.00115478202f, 0.00100000005f, 0.000865964335f, 0.000749894185f, 0.000649381604f, 0.000562341302f, 0.000486967532f, 0.000421696517f, 0.000365174114f, 0.000316227757f, 0.000273841957f, 0.00023713737f, 0.00020535251f, 0.00017782794f, 0.00015399266f, 0.00013335215f, 0.0001154782f};
    return T[i];
}
__device__ __forceinline__ void tr_item(const float* W, int Nsrc, int scol, const float* gv, const float* bv, bf16* WT, int K, int n0, float* gW, float* bW, LAS float* scr, int k0, int lane) {
    float bacc = 0.f;
#pragma unroll 8
    for (int i = 0; i < 32; ++i) { const int kk = 2 * i + (lane >> 5); float w = W[(size_t)(k0 + kk) * Nsrc + scol];
        if (gv) { bacc += w * bv[k0 + kk]; w *= gv[k0 + kk]; }
        scr[kk * 33 + (lane & 31)] = w; }
    LDS_WAIT(); asm volatile("" ::: "memory");
    const int c = lane & 7;
#pragma unroll
    for (int j = 0; j < 4; ++j) { const int n = (lane >> 3) + 8 * j; const LAS float* s = scr + (8 * c) * 33 + n;
        unsigned h[8]; float gs = 0.f;
#pragma unroll
        for (int e = 0; e < 8; ++e) { h[e] = f2bf(s[e * 33]); gs += bf2f(h[e]); }
        v4u o; o.x = h[0] | (h[1] << 16); o.y = h[2] | (h[3] << 16); o.z = h[4] | (h[5] << 16); o.w = h[6] | (h[7] << 16);
        *(v4u*)(WT + (size_t)(n0 + n) * K + k0 + 8 * c) = o;
        if (gv) { gs += __shfl_xor(gs, 1); gs += __shfl_xor(gs, 2); gs += __shfl_xor(gs, 4); if (c == 0) atomicAdd(gW + n0 + n, gs); } }
    if (gv) { bacc += __shfl_xor(bacc, 32); if (lane < 32) atomicAdd(bW + n0 + lane, bacc); }
    LDS_WAIT(); asm volatile("" ::: "memory");
}
__device__ __forceinline__ void p0_prologue(Frame& F) {
    unsigned char* ws = F.ws;
    LAS float* scr = (LAS float*)(F.lds + F.wave * 16384);
    const int gw = blockIdx.x * NWAVES + F.wave, NGW = gridDim.x * NWAVES, lane = F.lane;
    const int gtid = blockIdx.x * (NWAVES * 64) + F.tid, NT = gridDim.x * NWAVES * 64;
    constexpr int I_IN = 16 * 128, I_O = 16 * 32, I_AB = 16 * 176, I_D = 44 * 32, I_L = I_IN + I_O + I_AB + I_D;
    for (int it = gw; it < DEPTH * I_L; it += NGW) {
        const int l = it / I_L; int r = it - l * I_L;
        if (r < I_IN) { const int kb = r / 128, nb = r % 128, n0 = 32 * nb;
            const float* gv = l ? F.in[I_L2G] + (l - 1) * D : nullptr; const float* bv = l ? F.in[I_L2B] + (l - 1) * D : nullptr;
            tr_item(F.in[I_WIN] + (size_t)l * D * NPROJ, NPROJ, win_src_col(n0 + (lane & 31)), gv, bv, w_ptr(ws, l, W_IN), D, n0, gw_ptr(ws, l, 0), gw_ptr(ws, l, 1), scr, 64 * kb, lane); continue; }
        r -= I_IN;
        if (r < I_O) { const int kb = r / 32, nb = r % 32, n0 = 32 * nb;
            tr_item(F.in[I_WO] + (size_t)l * D * D, D, n0 + (lane & 31), nullptr, nullptr, w_ptr(ws, l, W_O), D, n0, nullptr, nullptr, scr, 64 * kb, lane); continue; }
        r -= I_O;
        if (r < I_AB) { const int kb = r / 176, nb = r % 176, n0 = 32 * nb, tile = n0 >> 8, bj = (n0 >> 7) & 1, jj = (n0 & 127) + (lane & 31);
            const float* W = (bj ? F.in[I_WB] : F.in[I_WA]) + (size_t)l * D * DFF;
            tr_item(W, DFF, 128 * tile + jj, F.in[I_L1G] + l * D, F.in[I_L1B] + l * D, w_ptr(ws, l, W_AB), D, n0, gw_ptr(ws, l, 2), gw_ptr(ws, l, 3), scr, 64 * kb, lane); continue; }
        r -= I_AB;
        { const int kb = r / 32, nb = r % 32, n0 = 32 * nb;
            tr_item(F.in[I_WD] + (size_t)l * DFF * D, D, n0 + (lane & 31), nullptr, nullptr, w_ptr(ws, l, W_DN), DFF, n0, nullptr, nullptr, scr, 64 * kb, lane); }
    }
    float* lb = (float*)(ws + WS_SMALL + SM_LB);
    if (gtid < HGW) { const float* L = F.in[I_LBL]; const float a0 = L[gtid], a1 = L[HGW + gtid], a2 = L[2 * HGW + gtid], a3 = L[3 * HGW + gtid];
        const float mx = fmaxf(fmaxf(a0, a1), fmaxf(a2, a3)); const float e0 = expf(a0 - mx), e1 = expf(a1 - mx), e2 = expf(a2 - mx), e3 = expf(a3 - mx), inv = 1.0f / (e0 + e1 + e2 + e3);
        lb[gtid] = 0.f; lb[HGW + gtid] = e1 * inv; lb[2 * HGW + gtid] = (e1 + e2) * inv; lb[3 * HGW + gtid] = (e1 + e2 + e3) * inv; }
    if (gtid >= 1024 && gtid < 2048) ((float*)(ws + WS_SMALL + SM_ONES))[gtid - 1024] = 1.0f;
    { f32x2* st = stats_ptr(ws, 0); for (int r = gtid; r < MPAD; r += NT) st[r] = (f32x2){0.f, 1024.0f * (1.0f - LN_EPS)}; }
    { f32x2* rope = (f32x2*)(ws + WS_SMALL + SM_ROPE);
      for (int e = gtid; e < NPOS * 64; e += NT) { const int pi = e >> 6, i = e & 63; const int pos = pi < TP ? pi : 16384 + (pi - TP);
          const float ang = (float)pos * rope_inv(i);
          double q = (double)ang * 0.15915494309189535; q -= __builtin_rint(q);
          const float fr = (float)q;
          rope[e] = (f32x2){__builtin_amdgcn_cosf(fr), __builtin_amdgcn_sinf(fr)}; } }
    float* Y = (float*)(ws + WS_Y); bf16* YB = (bf16*)(ws + WS_YB);
    const float* eg = F.in[I_EG]; const float* eb = F.in[I_EB];
    for (int row = gw; row < MPAD; row += NGW) {
        f32x4* yo = (f32x4*)(Y + (size_t)row * D) + lane; v2u* bo = (v2u*)(YB + (size_t)row * D) + lane;
        if (row >= MREAL) {
#pragma unroll
            for (int j = 0; j < 4; ++j) { yo[64 * j] = (f32x4){0.f, 0.f, 0.f, 0.f}; bo[64 * j] = (v2u){0u, 0u}; }
            continue; }
        const float* src;
        if (row < MP) { const int b = row / TP, t = row - b * TP; src = t < NMETA ? F.in[I_META] + (size_t)t * D : F.in[I_XP] + ((size_t)b * SEQP + (t - NMETA)) * D; }
        else src = F.in[I_XS] + (size_t)(row - MP) * D;
        const f32x4* xr = (const f32x4*)src + lane;
        f32x4 v[4]; float s = 0.f;
#pragma unroll
        for (int j = 0; j < 4; ++j) { v[j] = xr[64 * j]; s += (v[j].x + v[j].y) + (v[j].z + v[j].w); }
        const float mean = wave_sum(s) * (1.f / D); float s2 = 0.f;
#pragma unroll
        for (int j = 0; j < 4; ++j) { v[j] = v[j] - mean; s2 += (v[j].x * v[j].x + v[j].y * v[j].y) + (v[j].z * v[j].z + v[j].w * v[j].w); }
        const float rstd = 1.f / sqrtf(wave_sum(s2) * (1.f / D) + LN_EPS);
#pragma unroll
        for (int j = 0; j < 4; ++j) { const f32x4 g = ((const f32x4*)eg)[lane + 64 * j], b = ((const f32x4*)eb)[lane + 64 * j]; const f32x4 y = v[j] * rstd * g + b;
            yo[64 * j] = y; bo[64 * j] = (v2u){pk2(y.x, y.y), pk2(y.z, y.w)}; }
    }
}

using pg8::Unit;
struct EpiIn {
    static constexpr bool PERM = true, AFTER_DRAIN = false;
    const f32x2* st; const float* gW; const float* bW; const float* lb; const f32x2* rope;
    bf16* QT; bf16* KT; bf16* VR; bf16* GT; float* DEC; float* DECS;
    template <int TYPE>
    __device__ __forceinline__ void run(const f32x4 (&acc)[2][2][4][2], const Unit& u, int wr, int wc, int fr, int fq) const {
        const int pn = u.pn, jj0 = wc * 32 + 8 * fq;
        f32x4 lbv[2] = {(f32x4){0.f, 0.f, 0.f, 0.f}, (f32x4){0.f, 0.f, 0.f, 0.f}};
        if (TYPE == 0) { lbv[0] = *(const f32x4*)(lb + 128 * pn + jj0); lbv[1] = *(const f32x4*)(lb + 128 * pn + jj0 + 4); }
        const int hd = 2 * (pn & 1) + (jj0 >> 6), i0 = jj0 & 63;
        const float lg = log1pf(-exp2f(-5.0f - (float)hd));
        const int cb12 = ((pn & 8) ? 512 : 0) + 256 * (pn & 1);
#pragma unroll
        for (int ai = 0; ai < 2; ++ai) {
            const int rowbase = u.pm * 256 + ai * 128 + wr * 64;
            const bool smp = rowbase >= MP;
            const int tau = smp ? (fr & 3) : fr;
#pragma unroll
            for (int m = 0; m < 4; ++m) {
                const int row = rowbase + 16 * m + fr;
                const f32x2 s = st[row]; const float mu = s.x * (1.f / D), rstd = rsqrtf(s.y * (1.f / D) - mu * mu + LN_EPS);
                f32x4 v[2][2];
#pragma unroll
                for (int bj = 0; bj < 2; ++bj)
#pragma unroll
                    for (int n = 0; n < 2; ++n) { const f32x4 gwv = *(const f32x4*)(gW + 256 * pn + 128 * bj + jj0 + 4 * n), bwv = *(const f32x4*)(bW + 256 * pn + 128 * bj + jj0 + 4 * n);
                        v[bj][n] = (acc[ai][bj][m][n] - mu * gwv) * rstd + bwv; }
                if (TYPE == 0) {
                    float qt[8], kt[8], bb[8];
#pragma unroll
                    for (int n = 0; n < 2; ++n)
#pragma unroll
                        for (int i = 0; i < 4; ++i) { const float hq = v[0][n][i], hf = v[1][n][i], l0 = lbv[n][i];
                            const float sg = sigmoidf_(hf), f = l0 + (1.f - l0) * sg; float b = __logf(fmaxf(f, F_EPS));
                            const float kk = (1.f - l0) * (1.f - sg), q = hq * sigmoidf_(hq);
                            { float y = __shfl_up(b, 1, 16); if (tau >= 1) b += y; y = __shfl_up(b, 2, 16); if (tau >= 2) b += y;
                              if (!smp) { y = __shfl_up(b, 4, 16); if (tau >= 4) b += y; y = __shfl_up(b, 8, 16); if (tau >= 8) b += y; } }
                            bb[4 * n + i] = b; qt[4 * n + i] = q * __expf(b); kt[4 * n + i] = kk * __expf(-b); }
                    const size_t o = (size_t)row * D + 128 * pn + jj0;
                    *(v4u*)(QT + o) = (v4u){pk2(qt[0], qt[1]), pk2(qt[2], qt[3]), pk2(qt[4], qt[5]), pk2(qt[6], qt[7])};
                    *(v4u*)(KT + o) = (v4u){pk2(kt[0], kt[1]), pk2(kt[2], kt[3]), pk2(kt[4], kt[5]), pk2(kt[6], kt[7])};
                    if (!smp) { if (fr == 15) { float* d = DEC + (size_t)(row >> 4) * HGW + 128 * pn + jj0; *(f32x4*)d = (f32x4){bb[0], bb[1], bb[2], bb[3]}; *(f32x4*)(d + 4) = (f32x4){bb[4], bb[5], bb[6], bb[7]}; } }
                    else if ((fr & 3) == 3) { float* d = DECS + (size_t)((row - MP) >> 2) * HGW + 128 * pn + jj0; *(f32x4*)d = (f32x4){bb[0], bb[1], bb[2], bb[3]}; *(f32x4*)(d + 4) = (f32x4){bb[4], bb[5], bb[6], bb[7]}; }
                } else if (TYPE == 1 || TYPE == 2) {
                    bf16* dst = (TYPE == 1 ? VR : GT) + (size_t)row * D + cb12 + jj0;
#pragma unroll
                    for (int bj = 0; bj < 2; ++bj) { f32x4 a = v[bj][0], b = v[bj][1];
                        if (TYPE == 2) {
#pragma unroll
                            for (int i = 0; i < 4; ++i) { a[i] = a[i] * sigmoidf_(a[i]); b[i] = b[i] * sigmoidf_(b[i]); } }
                        *(v4u*)(dst + 128 * bj) = (v4u){pk2(a[0], a[1]), pk2(a[2], a[3]), pk2(b[0], b[1]), pk2(b[2], b[3])}; }
                } else {
                    const int pi = smp ? TP + ((row - MP) & 3) : row - TP * (row / TP);
                    const f32x4* cs = (const f32x4*)(rope + (size_t)pi * 64 + i0);
                    const float sc = TYPE == 3 ? __expf((float)(tau + 1) * lg) : RT_KSCALE * __expf(-(float)(tau + 1) * lg);
                    float o1[8], o2[8];
#pragma unroll
                    for (int p = 0; p < 4; ++p) { const f32x4 c2 = cs[p];
#pragma unroll
                        for (int e = 0; e < 2; ++e) { const int j = 2 * p + e; const float c = c2[2 * e], sn = c2[2 * e + 1], x1 = v[0][j >> 2][j & 3], x2 = v[1][j >> 2][j & 3];
                            o1[j] = (x1 * c - x2 * sn) * sc; o2[j] = (x1 * sn + x2 * c) * sc; } }
                    bf16* dst = (TYPE == 3 ? QT : KT) + (size_t)row * D + HGW + 128 * hd + i0;
                    *(v4u*)dst = (v4u){pk2(o1[0], o1[1]), pk2(o1[2], o1[3]), pk2(o1[4], o1[5]), pk2(o1[6], o1[7])};
                    *(v4u*)(dst + 64) = (v4u){pk2(o2[0], o2[1]), pk2(o2[2], o2[3]), pk2(o2[4], o2[5]), pk2(o2[6], o2[7])};
                }
                asm volatile("" ::: "memory");
            }
        }
    }
    __device__ __forceinline__ void operator()(const f32x4 (&acc)[2][2][4][2], const Unit& u, int wr, int wc, int fr, int fq) const {
        const int pn = u.pn;
        if (pn < 4) run<0>(acc, u, wr, wc, fr, fq);
        else if (pn == 4 || pn == 5 || pn == 12 || pn == 13) run<1>(acc, u, wr, wc, fr, fq);
        else if (pn == 6 || pn == 7 || pn >= 14) run<2>(acc, u, wr, wc, fr, fq);
        else if (pn < 10) run<3>(acc, u, wr, wc, fr, fq);
        else run<4>(acc, u, wr, wc, fr, fq);
    }
};
struct EpiRes {
    static constexpr bool PERM = false, AFTER_DRAIN = false;
    const float* Yin; float* Yout; bf16* YB; const f32x2* st_in; const float* g; const float* b; f32x2* st_out;
    __device__ __forceinline__ void operator()(const f32x4 (&acc)[2][2][4][2], const Unit& u, int wr, int wc, int fr, int fq) const {
        const int col0 = u.pn * 256 + wc * 32 + 4 * fq;
        f32x4 gv[2][2], bv[2][2];
#pragma unroll
        for (int bj = 0; bj < 2; ++bj)
#pragma unroll
            for (int n = 0; n < 2; ++n) { gv[bj][n] = *(const f32x4*)(g + col0 + 128 * bj + 16 * n); bv[bj][n] = *(const f32x4*)(b + col0 + 128 * bj + 16 * n); }
#pragma unroll
        for (int ai = 0; ai < 2; ++ai)
#pragma unroll
            for (int m = 0; m < 4; ++m) {
                const int row = u.pm * 256 + ai * 128 + wr * 64 + 16 * m + fr;
                const f32x2 s = st_in[row]; const float mu = s.x * (1.f / D), rstd = rsqrtf(s.y * (1.f / D) - mu * mu + LN_EPS);
                const size_t off = (size_t)row * D + col0; float sy = 0.f, sq = 0.f;
#pragma unroll
                for (int bj = 0; bj < 2; ++bj)
#pragma unroll
                    for (int n = 0; n < 2; ++n) { const f32x4 yi = *(const f32x4*)(Yin + off + 128 * bj + 16 * n);
                        const f32x4 x = (yi - mu) * rstd * gv[bj][n] + bv[bj][n]; const f32x4 y = ALPHA * x + acc[ai][bj][m][n];
                        *(f32x4*)(Yout + off + 128 * bj + 16 * n) = y; *(v2u*)(YB + off + 128 * bj + 16 * n) = (v2u){pk2(y[0], y[1]), pk2(y[2], y[3])};
                        sy += (y[0] + y[1]) + (y[2] + y[3]); sq += (y[0] * y[0] + y[1] * y[1]) + (y[2] * y[2] + y[3] * y[3]); }
                sy += __shfl_xor(sy, 16); sy += __shfl_xor(sy, 32); sq += __shfl_xor(sq, 16); sq += __shfl_xor(sq, 32);
                if (fq == 0) { float* so = (float*)(st_out + row); atomicAdd(so, sy); atomicAdd(so + 1, sq); }
                if (m & 1) asm volatile("" ::: "memory");
            }
    }
};
struct EpiUp {
    static constexpr bool PERM = true, AFTER_DRAIN = false;
    const f32x2* st; const float* gW; const float* bW; bf16* A; bf16* G;
    __device__ __forceinline__ void operator()(const f32x4 (&acc)[2][2][4][2], const Unit& u, int wr, int wc, int fr, int fq) const {
        const int pn = u.pn, jj0 = wc * 32 + 8 * fq;
        f32x4 gw[2][2], bw[2][2];
#pragma unroll
        for (int bj = 0; bj < 2; ++bj)
#pragma unroll
            for (int n = 0; n < 2; ++n) { gw[bj][n] = *(const f32x4*)(gW + 256 * pn + 128 * bj + jj0 + 4 * n); bw[bj][n] = *(const f32x4*)(bW + 256 * pn + 128 * bj + jj0 + 4 * n); }
#pragma unroll
        for (int ai = 0; ai < 2; ++ai)
#pragma unroll
            for (int m = 0; m < 4; ++m) {
                const int row = u.pm * 256 + ai * 128 + wr * 64 + 16 * m + fr;
                const f32x2 s = st[row]; const float mu = s.x * (1.f / D), rstd = rsqrtf(s.y * (1.f / D) - mu * mu + LN_EPS);
                const size_t o = (size_t)row * DFF + 128 * pn + jj0;
#pragma unroll
                for (int bj = 0; bj < 2; ++bj) { const f32x4 a = (acc[ai][bj][m][0] - mu * gw[bj][0]) * rstd + bw[bj][0], b = (acc[ai][bj][m][1] - mu * gw[bj][1]) * rstd + bw[bj][1];
                    *(v4u*)((bj ? G : A) + o) = (v4u){pk2(a[0], a[1]), pk2(a[2], a[3]), pk2(b[0], b[1]), pk2(b[2], b[3])}; }
            }
    }
};

__device__ __forceinline__ void mixer_naive(Frame& F, int l) {
    unsigned char* ws = F.ws;
    const int tid = F.tid, v = tid & 127, kq = tid >> 7;
    LAS unsigned char* L = F.lds;
    LAS bf16* TL = (LAS bf16*)L;
    LAS float* Es = (LAS float*)(L + 16384);
    LAS float* OP = (LAS float*)(L + 16384 + 512);
    const bf16* QT = (const bf16*)(ws + WS_R + R_QT); const bf16* KT = (const bf16*)(ws + WS_R + R_KT); const bf16* VR = (const bf16*)(ws + WS_R + R_VR); const bf16* GT = (const bf16*)(ws + WS_R + R_GT);
    bf16* O = (bf16*)(ws + WS_R + R_O);
    const float* DEC = (const float*)(ws + WS_R + R_DEC); const float* DECS = (const float*)(ws + WS_R + R_DECS);
    const int w = blockIdx.x;
    for (int it = 0;; ++it) {
        bool smp; int seq, H, nchunks, ntok, row_base;
        if (w < 64) { if (it > 0) break; smp = false; seq = w >> 3; H = w & 7; nchunks = TP / 16; ntok = 16; row_base = seq * TP; }
        else { const int id = (w - 64) + (int)(gridDim.x - 64) * it; if (id >= NS * 8) break; smp = true; seq = id >> 3; H = id & 7; nchunks = 1; ntok = 4; row_base = MP + 4 * seq; }
        const bool hg = H < 4; const int h = H & 3;
        float Z[32];
        if (smp) { const float* S0 = (hg ? F.in[I_SHG] : F.in[I_SRT]) + (((size_t)l * NS + seq) * 4 + h) * 16384;
#pragma unroll
            for (int j = 0; j < 32; ++j) Z[j] = S0[(kq * 32 + j) * 128 + v]; }
        else {
#pragma unroll
            for (int j = 0; j < 32; ++j) Z[j] = 0.f; }
        const float lg = log1pf(-exp2f(-5.0f - (float)h)), Eret = __expf(lg * (float)ntok);
        const float* nrm_g = hg ? F.in[I_HGN] + l * HGW + 128 * h : F.in[I_GNG] + l * HGW + 128 * h;
        const float* nrm_b = F.in[I_GNB] + l * HGW + 128 * h;
        for (int c = 0; c < nchunks; ++c) {
            const int row0 = row_base + 16 * c;
            { const int tile = tid >> 7, p = tid & 127; const bf16* src = tile == 0 ? QT : tile == 1 ? KT : tile == 2 ? VR : GT;
#pragma unroll
              for (int rr = 0; rr < 2; ++rr) { const int r = (p >> 4) + 8 * rr; v4u x = (v4u){0u, 0u, 0u, 0u};
                  if (r < ntok) x = *(const v4u*)(src + (size_t)(row0 + r) * D + 128 * H + (p & 15) * 8);
                  *(LAS v4u*)(TL + tile * 2048 + r * 128 + (p & 15) * 8) = x; } }
            if (tid < 128) Es[tid] = hg ? __expf(smp ? DECS[(size_t)seq * HGW + 128 * h + tid] : DEC[(size_t)(row0 >> 4) * HGW + 128 * h + tid]) : Eret;
            __syncthreads();
            for (int t = 0; t < ntok; ++t) {
                const float vv = bf2f(TL[2 * 2048 + t * 128 + v]);
                float op = 0.f;
#pragma unroll
                for (int j4 = 0; j4 < 4; ++j4) { const v4u kw = *(const LAS v4u*)(TL + 2048 + t * 128 + kq * 32 + 8 * j4), qw = *(const LAS v4u*)(TL + t * 128 + kq * 32 + 8 * j4);
#pragma unroll
                    for (int e = 0; e < 4; ++e) { const unsigned ku = kw[e], qu = qw[e];
                        Z[8 * j4 + 2 * e] = fmaf(bflo(ku), vv, Z[8 * j4 + 2 * e]); op = fmaf(Z[8 * j4 + 2 * e], bflo(qu), op);
                        Z[8 * j4 + 2 * e + 1] = fmaf(bfhi(ku), vv, Z[8 * j4 + 2 * e + 1]); op = fmaf(Z[8 * j4 + 2 * e + 1], bfhi(qu), op); } }
                OP[(t * 4 + kq) * 128 + v] = op;
            }
            __syncthreads();
            { const int tt = tid >> 5, v4 = (tid & 31) * 4;
              f32x4 o = (f32x4){0.f, 0.f, 0.f, 0.f};
              if (tt < ntok) {
#pragma unroll
                  for (int q = 0; q < 4; ++q) o += *(const LAS f32x4*)(OP + (tt * 4 + q) * 128 + v4); }
              float s = (o[0] + o[1]) + (o[2] + o[3]), ss = (o[0] * o[0] + o[1] * o[1]) + (o[2] * o[2] + o[3] * o[3]);
#pragma unroll
              for (int x = 1; x < 32; x <<= 1) { s += __shfl_xor(s, x); ss += __shfl_xor(ss, x); }
              const v2u gwd = *(const LAS v2u*)(TL + 3 * 2048 + tt * 128 + v4);
              const float gt[4] = {bflo(gwd.x), bfhi(gwd.x), bflo(gwd.y), bfhi(gwd.y)};
              const f32x4 ng = *(const f32x4*)(nrm_g + v4);
              float r[4];
              if (hg) { const float rs = rsqrtf(ss * (1.f / 128.f) + LN_EPS);
#pragma unroll
                  for (int i = 0; i < 4; ++i) r[i] = o[i] * rs * ng[i] * gt[i]; }
              else { const f32x4 nb = *(const f32x4*)(nrm_b + v4); const float mean = s * (1.f / 128.f), rs = rsqrtf(ss * (1.f / 128.f) - mean * mean + LN_EPS);
#pragma unroll
                  for (int i = 0; i < 4; ++i) r[i] = ((o[i] - mean) * rs * ng[i] + nb[i]) * gt[i]; }
              if (tt < ntok) *(v2u*)(O + (size_t)(row0 + tt) * D + 128 * H + v4) = (v2u){pk2(r[0], r[1]), pk2(r[2], r[3])}; }
#pragma unroll
            for (int j = 0; j < 32; ++j) Z[j] *= Es[kq * 32 + j];
            __syncthreads();
        }
        float* dst = F.out + (smp ? (hg ? O_HS : O_RS) + (((size_t)l * NS + seq) * 4 + h) * 16384 : (hg ? O_HP : O_RP) + (((size_t)l * NB + seq) * 4 + h) * 16384);
#pragma unroll
        for (int j = 0; j < 32; ++j) dst[(kq * 32 + j) * 128 + v] = Z[j];
    }
}

__device__ __forceinline__ void unpack8(const v4u w, float (&f)[8]) {
#pragma unroll
    for (int e = 0; e < 4; ++e) { f[2 * e] = bflo(w[e]); f[2 * e + 1] = bfhi(w[e]); }
}
__device__ __forceinline__ float gelu_tanh(float x) { const float u = 0.7978845608028654f * (x + 0.044715f * x * x * x); return x / (1.0f + __expf(-2.0f * u)); }
__device__ __forceinline__ void conv_phase(Frame& F, int l) {
    unsigned char* ws = F.ws;
    const bf16* A = (const bf16*)(ws + WS_R + R_A); bf16* G = (bf16*)(ws + WS_R + R_G);
    const float* cw = F.in[I_CW] + (size_t)l * 3 * DFF; const float* cb = F.in[I_CB] + (size_t)l * DFF;
    const float* scv = F.in[I_SCV] + (size_t)l * NS * 2 * DFF;
    float* ocp = F.out + O_CP + (size_t)l * NB * 2 * DFF; float* ocs = F.out + O_CS + (size_t)l * NS * 2 * DFF;
    constexpr int FG = DFF / 8  , NRC = MPAD / 16  ;
    const int gtid = blockIdx.x * (NWAVES * 64) + F.tid, NT = gridDim.x * NWAVES * 64;
    for (int item = gtid; item < NRC * FG; item += NT) {
        const int rc = item / FG, fg = item - rc * FG, f0 = fg * 8, row0 = rc * 16;
        if (row0 >= MREAL) { for (int r = 0; r < 16; ++r) *(v4u*)(G + (size_t)(row0 + r) * DFF + f0) = (v4u){0u, 0u, 0u, 0u}; continue; }
        float w0[8], w1[8], w2[8], bb[8];
#pragma unroll
        for (int e = 0; e < 8; ++e) { w0[e] = cw[f0 + e]; w1[e] = cw[DFF + f0 + e]; w2[e] = cw[2 * DFF + f0 + e]; bb[e] = cb[f0 + e]; }
        const bool smp = row0 >= MP;
        float a1[8], a2[8];
        const int tseq = smp ? 0 : row0 - TP * (row0 / TP);
        if (!smp && tseq > 0) { unpack8(*(const v4u*)(A + (size_t)(row0 - 1) * DFF + f0), a1); unpack8(*(const v4u*)(A + (size_t)(row0 - 2) * DFF + f0), a2); }
        else {
#pragma unroll
            for (int e = 0; e < 8; ++e) { a1[e] = 0.f; a2[e] = 0.f; } }
        for (int r = 0; r < 16; ++r) {
            const int row = row0 + r;
            if (smp && (r & 3) == 0) { const int s = (row - MP) >> 2;
#pragma unroll
                for (int e = 0; e < 8; ++e) { a2[e] = scv[((size_t)s * 2 + 0) * DFF + f0 + e]; a1[e] = scv[((size_t)s * 2 + 1) * DFF + f0 + e]; } }
            float a0[8], g[8], hh[8];
            unpack8(*(const v4u*)(A + (size_t)row * DFF + f0), a0); unpack8(*(const v4u*)(G + (size_t)row * DFF + f0), g);
#pragma unroll
            for (int e = 0; e < 8; ++e) { const float cv = bb[e] + w0[e] * a2[e] + w1[e] * a1[e] + w2[e] * a0[e]; hh[e] = gelu_tanh(cv) * g[e]; }
            *(v4u*)(G + (size_t)row * DFF + f0) = (v4u){pk2(hh[0], hh[1]), pk2(hh[2], hh[3]), pk2(hh[4], hh[5]), pk2(hh[6], hh[7])};
            if (!smp) { const int t = tseq + r; if (t >= TP - 2) { float* d = ocp + ((size_t)(row0 / TP) * 2 + (t - (TP - 2))) * DFF + f0;
#pragma unroll
                    for (int e = 0; e < 8; ++e) d[e] = a0[e]; } }
            else if ((r & 3) >= 2) { float* d = ocs + ((size_t)((row - MP) >> 2) * 2 + ((r & 3) - 2)) * DFF + f0;
#pragma unroll
                for (int e = 0; e < 8; ++e) d[e] = a0[e]; }
#pragma unroll
            for (int e = 0; e < 8; ++e) { a2[e] = a1[e]; a1[e] = a0[e]; }
        }
    }
}

__device__ __forceinline__ void final_phase(Frame& F) {
    unsigned char* ws = F.ws;
    const float* Y = (const float*)(ws + WS_Y); const f32x2* st = stats_ptr(ws, 4);
    const float* g = F.in[I_L2G] + 3 * D; const float* b = F.in[I_L2B] + 3 * D;
    const int gw = blockIdx.x * NWAVES + F.wave, NGW = gridDim.x * NWAVES, lane = F.lane;
    for (int row = gw; row < MREAL; row += NGW) {
        float* dst;
        if (row < MP) { const int bb = row / TP, t = row - bb * TP; if (t < NMETA) continue; dst = F.out + O_YP + ((size_t)bb * SEQP + (t - NMETA)) * D; }
        else dst = F.out + O_YS + (size_t)(row - MP) * D;
        const f32x2 s = st[row]; const float mu = s.x * (1.f / D), rstd = rsqrtf(s.y * (1.f / D) - mu * mu + LN_EPS);
#pragma unroll
        for (int j = 0; j < 4; ++j) { const f32x4 y = ((const f32x4*)(Y + (size_t)row * D))[lane + 64 * j]; const f32x4 gg = ((const f32x4*)g)[lane + 64 * j], bb = ((const f32x4*)b)[lane + 64 * j];
            ((f32x4*)dst)[lane + 64 * j] = (y - mu) * rstd * gg + bb; }
    }
}

#ifndef ONE_LAUNCH
#define ONE_LAUNCH 1
#endif
constexpr int NPHASES = 2 + 6 * DEPTH;
struct Args { const float* in[23]; float* out; unsigned char* ws; int ph_lo, ph_hi; };
template <int ONLY_SUB> __global__ void __launch_bounds__(NWAVES * 64, 2) hymba_fwd(Args args) {
    extern __shared__ __attribute__((aligned(16))) unsigned char lds[];
    Frame F;
    F.lds = (LAS unsigned char*)lds;
    F.tid = threadIdx.x; F.lane = F.tid & 63; F.wave = __builtin_amdgcn_readfirstlane(F.tid >> 6);
    F.in = args.in; F.out = args.out; F.ws = args.ws;
    for (int u = F.tid; u < (LDS_BYTES - LDSCTL_OFF) / 4; u += NWAVES * 64) ((LAS unsigned*)(F.lds + LDSCTL_OFF))[u] = 0u;
    __syncthreads();
#if ONE_LAUNCH
    XcdBarrier bar = xcd_barrier_post((unsigned*)(args.ws + WS_CTL) + CW_BAR, (volatile LAS unsigned*)(F.lds + MISC_OFF) + 8);
#define SEAM() xcd_barrier(bar)
#else
#define SEAM() do {} while (0)
#endif
    const int lo = args.ph_lo, hi = args.ph_hi;
    const int G = gridDim.x, cid = blockIdx.x;
#ifndef SUBMASK
#define SUBMASK 0xFFFF
#endif
#define SUBON(x) ((ONLY_SUB < 0 && ((SUBMASK >> (x)) & 1)) || ONLY_SUB == (x))
    if (lo == 0 && SUBON(10)) { p0_prologue(F); if (hi > 1) SEAM(); }
    for (int ph = (lo > 1 ? lo : 1); ph < (hi < NPHASES - 1 ? hi : NPHASES - 1); ++ph) {
        { int t_ = threadIdx.x; asm volatile("" : "+v"(t_)); F.tid = t_; F.lane = t_ & 63; F.wave = __builtin_amdgcn_readfirstlane(t_ >> 6);
          unsigned long long w_ = (unsigned long long)args.ws, o_ = (unsigned long long)args.out; asm volatile("" : "+s"(w_), "+s"(o_));
          F.ws = (unsigned char*)w_; F.out = (float*)o_; }
        unsigned char* ws = F.ws;
        {
            const int l = (ph - 1) / 6, sub = (ph - 1) % 6;
            if (sub == 0 && SUBON(0)) {
                pg8::Gemm g{(const bf16*)(ws + WS_YB), w_ptr(ws, l, W_IN), MPAD, NPROJ, D}; pg8::StaticOrder S; S.init(MPAD, NPROJ, G, cid);
                EpiIn E{stats_ptr(ws, l), gw_ptr(ws, l, 0), gw_ptr(ws, l, 1), (const float*)(ws + WS_SMALL + SM_LB) + l * HGW, (const f32x2*)(ws + WS_SMALL + SM_ROPE),
                        (bf16*)(ws + WS_R + R_QT), (bf16*)(ws + WS_R + R_KT), (bf16*)(ws + WS_R + R_VR), (bf16*)(ws + WS_R + R_GT), (float*)(ws + WS_R + R_DEC), (float*)(ws + WS_R + R_DECS)};
                pg8::gemm_phase<EpiIn, pg8::StaticOrder, true, true>(F.lds, g, S, E);
            } else if (sub == 1 && SUBON(1)) {
                mixer_naive(F, l);
            } else if (sub == 2 && SUBON(2)) {
                pg8::Gemm g{(const bf16*)(ws + WS_R + R_O), w_ptr(ws, l, W_O), MPAD, D, D}; pg8::StaticOrder S; S.init(MPAD, D, G, cid);
                const float* lg = l ? F.in[I_L2G] + (l - 1) * D : (const float*)(ws + WS_SMALL + SM_ONES);
                const float* lb = l ? F.in[I_L2B] + (l - 1) * D : (const float*)(ws + WS_CTL + 1024);
                EpiRes E{(const float*)(ws + WS_Y), (float*)(ws + WS_Y1), (bf16*)(ws + WS_YB), stats_ptr(ws, l), lg, lb, stats_ptr(ws, 5 + l)};
                pg8::gemm_phase<EpiRes, pg8::StaticOrder, true, true>(F.lds, g, S, E);
            } else if (sub == 3 && SUBON(3)) {
                pg8::Gemm g{(const bf16*)(ws + WS_YB), w_ptr(ws, l, W_AB), MPAD, NAB, D}; pg8::StaticOrder S; S.init(MPAD, NAB, G, cid);
                EpiUp E{stats_ptr(ws, 5 + l), gw_ptr(ws, l, 2), gw_ptr(ws, l, 3), (bf16*)(ws + WS_R + R_A), (bf16*)(ws + WS_R + R_G)};
                pg8::gemm_phase<EpiUp, pg8::StaticOrder, true, true>(F.lds, g, S, E);
            } else if (sub == 4 && SUBON(4)) {
                conv_phase(F, l);
            } else if (SUBON(5)) {
                pg8::Gemm g{(const bf16*)(ws + WS_R + R_G), w_ptr(ws, l, W_DN), MPAD, D, DFF}; pg8::StaticOrder S; S.init(MPAD, D, G, cid);
                EpiRes E{(const float*)(ws + WS_Y1), (float*)(ws + WS_Y), (bf16*)(ws + WS_YB), stats_ptr(ws, 5 + l), F.in[I_L1G] + l * D, F.in[I_L1B] + l * D, stats_ptr(ws, l + 1)};
                pg8::gemm_phase<EpiRes, pg8::StaticOrder, true, true>(F.lds, g, S, E);
            }
        }
        if (ph + 1 < hi) SEAM();
    }
    if (hi == NPHASES && SUBON(11)) {
        { int t_ = threadIdx.x; asm volatile("" : "+v"(t_)); F.tid = t_; F.lane = t_ & 63; F.wave = __builtin_amdgcn_readfirstlane(t_ >> 6); F.ws = args.ws; F.out = args.out; }
        final_phase(F); }
}

extern "C" void kernel_launch(void* const* d_in, const int* in_sizes, int n_in, void* d_out, int out_size, void* d_ws, size_t ws_size, hipStream_t stream) {
    static int grid = 0;
    if (grid == 0) {
        if (n_in != 23 || out_size != (int)O_END || ws_size < WS_END) { fprintf(stderr, "kernel_launch: unexpected shapes: n_in %d out %d ws %zu (need %zu)\n", n_in, out_size, ws_size, (size_t)WS_END); grid = -1; return; }
        int dev = 0, cus = 0;
        if (hipGetDevice(&dev) != hipSuccess || hipDeviceGetAttribute(&cus, hipDeviceAttributeMultiprocessorCount, dev) != hipSuccess) { grid = -1; return; }
        bool ok = true;
#if ONE_LAUNCH
        ok = ok && hipFuncSetAttribute((const void*)hymba_fwd<-1>, hipFuncAttributeMaxDynamicSharedMemorySize, LDS_BYTES) == hipSuccess;
#else
        ok = ok && hipFuncSetAttribute((const void*)hymba_fwd<0>, hipFuncAttributeMaxDynamicSharedMemorySize, LDS_BYTES) == hipSuccess;
        ok = ok && hipFuncSetAttribute((const void*)hymba_fwd<1>, hipFuncAttributeMaxDynamicSharedMemorySize, LDS_BYTES) == hipSuccess;
        ok = ok && hipFuncSetAttribute((const void*)hymba_fwd<2>, hipFuncAttributeMaxDynamicSharedMemorySize, LDS_BYTES) == hipSuccess;
        ok = ok && hipFuncSetAttribute((const void*)hymba_fwd<3>, hipFuncAttributeMaxDynamicSharedMemorySize, LDS_BYTES) == hipSuccess;
        ok = ok && hipFuncSetAttribute((const void*)hymba_fwd<4>, hipFuncAttributeMaxDynamicSharedMemorySize, LDS_BYTES) == hipSuccess;
        ok = ok && hipFuncSetAttribute((const void*)hymba_fwd<5>, hipFuncAttributeMaxDynamicSharedMemorySize, LDS_BYTES) == hipSuccess;
        ok = ok && hipFuncSetAttribute((const void*)hymba_fwd<10>, hipFuncAttributeMaxDynamicSharedMemorySize, LDS_BYTES) == hipSuccess;
        ok = ok && hipFuncSetAttribute((const void*)hymba_fwd<11>, hipFuncAttributeMaxDynamicSharedMemorySize, LDS_BYTES) == hipSuccess;
#endif
        if (!ok) { fprintf(stderr, "kernel_launch: hipFuncSetAttribute failed\n"); grid = -1; return; }
        (void)hipGetLastError();
        grid = cus;
    }
    if (grid < 0) return;
    (void)hipMemsetAsync((char*)d_ws + WS_CTL, 0, CTL_ZERO_BYTES, stream);
    Args a{};
    for (int i = 0; i < 23; ++i) a.in[i] = (const float*)d_in[i];
    a.out = (float*)d_out; a.ws = (unsigned char*)d_ws;
#if ONE_LAUNCH
    a.ph_lo = 0; a.ph_hi = NPHASES;
    hipLaunchKernelGGL(hymba_fwd<-1>, dim3(grid), dim3(NWAVES * 64), LDS_BYTES, stream, a);
#else
    for (int p = 0; p < NPHASES; ++p) { a.ph_lo = p; a.ph_hi = p + 1;
        const int sub = p == 0 ? 10 : p == NPHASES - 1 ? 11 : (p - 1) % 6;
        switch (sub) {
            case 0: hipLaunchKernelGGL(hymba_fwd<0>, dim3(grid), dim3(NWAVES * 64), LDS_BYTES, stream, a); break;
            case 1: hipLaunchKernelGGL(hymba_fwd<1>, dim3(grid), dim3(NWAVES * 64), LDS_BYTES, stream, a); break;
            case 2: hipLaunchKernelGGL(hymba_fwd<2>, dim3(grid), dim3(NWAVES * 64), LDS_BYTES, stream, a); break;
            case 3: hipLaunchKernelGGL(hymba_fwd<3>, dim3(grid), dim3(NWAVES * 64), LDS_BYTES, stream, a); break;
            case 4: hipLaunchKernelGGL(hymba_fwd<4>, dim3(grid), dim3(NWAVES * 64), LDS_BYTES, stream, a); break;
            case 5: hipLaunchKernelGGL(hymba_fwd<5>, dim3(grid), dim3(NWAVES * 64), LDS_BYTES, stream, a); break;
            case 10: hipLaunchKernelGGL(hymba_fwd<10>, dim3(grid), dim3(NWAVES * 64), LDS_BYTES, stream, a); break;
            default: hipLaunchKernelGGL(hymba_fwd<11>, dim3(grid), dim3(NWAVES * 64), LDS_BYTES, stream, a); break;
        }
    }
#endif
}
```

```cpp
#include <hip/hip_runtime.h>
#include <cstdio>
#include <cstdint>
namespace pg8 {
#define PG8_LAS __attribute__((address_space(3)))
typedef unsigned short bf16_t;
typedef short bf16x8 __attribute__((ext_vector_type(8)));
typedef float f32x4 __attribute__((ext_vector_type(4)));
typedef unsigned u32x4 __attribute__((ext_vector_type(4)));
constexpr int BM = 256, BK = 64, HALF = 128, HTB = HALF * BK * 2  , STAGE_BYTES = 8 * HTB, NXCD = 8, WGM = 8;

__host__ __device__ __forceinline__ int lds_byte(int r, int c) { const int st = (r >> 4) * 2 + (c >> 5), rr = r & 15, cc = c & 31, ob = rr * 64 + cc * 2; return st * 1024 + (ob ^ (((ob >> 9) & 1) << 5)); }
__host__ __device__ __forceinline__ void stage_rc(int b, int& R, int& C) { const int st = b / 1024, sb = b % 1024, swz = sb ^ (((sb >> 9) & 1) << 5); R = (st >> 1) * 16 + swz / 64; C = (st & 1) * 32 + (swz % 64) / 2; }
__host__ __device__ __forceinline__ int perm32(int rho) { const int n = rho >> 4, i = rho & 15; return 8 * (i >> 2) + 4 * n + (i & 3); }

struct Unit { int pm, pn; };
struct Gemm { const bf16_t* A; const bf16_t* Bt; int M, N, K; };

struct StaticOrder {
    int nM, nN, nwg, G, c;
    __host__ __device__ void init(int M, int N, int G_, int c_) { nM = M / BM; nN = N / BM; nwg = nM * nN; G = G_; c = c_; }
    __host__ __device__ bool next(int i, Unit& u) const {
        const long L = (long)i * G + c; if (L >= nwg) return false;
        int wgid = (int)L; { const int q = nwg / NXCD, r = nwg % NXCD, xcd = wgid % NXCD, off = wgid / NXCD; wgid = (xcd < r ? xcd * (q + 1) : r * (q + 1) + (xcd - r) * q) + off; }
        const int nig = WGM * nN, gid = wgid / nig, fm = gid * WGM, gsz = (nM - fm) < WGM ? (nM - fm) : WGM;
        u.pm = fm + ((wgid % nig) % gsz); u.pn = (wgid % nig) / gsz; return true;
    }
    __device__ __forceinline__ void a_ready(const Unit&) const {}
    __device__ __forceinline__ void done(const Unit&) const {}
};

__device__ __forceinline__ unsigned cvt_pk_bf16(float lo, float hi) { unsigned r; asm volatile("v_cvt_pk_bf16_f32 %0, %1, %2" : "=v"(r) : "v"(lo), "v"(hi)); return r; }
template <class Epi, class Sched, bool ALIGN_EPI = false, bool SP2 = false>
__device__ __forceinline__ void gemm_phase(PG8_LAS unsigned char* lds, const Gemm g, const Sched& S, const Epi& E) {
    int tid_ = threadIdx.x; asm volatile("" : "+v"(tid_));
    const int tid = tid_, wid = __builtin_amdgcn_readfirstlane(tid >> 6), lane = tid & 63, wr = wid >> 2, wc = wid & 3, fr = lane & 15, fq = lane >> 4;
    const int K = g.K, nt = K / BK;
    unsigned voffA[2], voffB[2];
#pragma unroll
    for (int i = 0; i < 2; ++i) { int R, C; stage_rc(tid * 16 + i * 8192, R, C); const int Rb = Epi::PERM ? ((R & ~31) + perm32(R & 31)) : R;
        voffA[i] = (unsigned)(R * K + C) * 2u; voffB[i] = (unsigned)(Rb * K + C) * 2u; }
    const size_t kstep = (size_t)(BK * 2);
    const size_t hstep = (size_t)HALF * K * 2;
    const size_t tstep = 2 * hstep;
    const unsigned ldsw = (unsigned)wid * 1024u;
    const int aoff = lds_byte(wr * 64 + fr, fq * 8), boff = lds_byte(wc * 32 + fr, fq * 8);
#define PG8_SA(b, h) (((b) * 2 + (h)) * HTB)
#define PG8_SB(b, h) ((4 + (b) * 2 + (h)) * HTB)
#define PG8_STAGE(bufoff, gbase, voff) do { _Pragma("unroll") for (int _i = 0; _i < 2; ++_i) \
        __builtin_amdgcn_global_load_lds((const unsigned*)((const char*)(gbase) + (voff)[_i]), (PG8_LAS unsigned*)(lds + (bufoff) + ldsw + _i * 8192), 16, 0, 0); } while (0)
#define PG8_LDA(dst, b, h) do { _Pragma("unroll") for (int m = 0; m < 4; ++m) _Pragma("unroll") for (int k = 0; k < 2; ++k) dst[m][k] = *(const PG8_LAS bf16x8*)(lds + PG8_SA(b, h) + aoff + m * 2048 + k * 1024); } while (0)
#define PG8_LDB(dst, b, h) do { _Pragma("unroll") for (int n = 0; n < 2; ++n) _Pragma("unroll") for (int k = 0; k < 2; ++k) dst[n][k] = *(const PG8_LAS bf16x8*)(lds + PG8_SB(b, h) + boff + n * 2048 + k * 1024); } while (0)
#define PG8_MMA(ai, bj, At, Bt) do { __builtin_amdgcn_s_setprio(1); _Pragma("unroll") for (int m = 0; m < 4; ++m) _Pragma("unroll") for (int n = 0; n < 2; ++n) _Pragma("unroll") for (int k = 0; k < 2; ++k) \
        acc[ai][bj][m][n] = __builtin_amdgcn_mfma_f32_16x16x32_bf16(Bt[n][k], At[m][k], acc[ai][bj][m][n], 0, 0, 0); __builtin_amdgcn_s_setprio(0); } while (0)
#define PG8_WAIT_V(n) asm volatile("s_waitcnt vmcnt(" #n ")" ::: "memory")
#define PG8_WAIT_L(n) asm volatile("s_waitcnt lgkmcnt(" #n ")" ::: "memory")
#define PG8_BAR __builtin_amdgcn_s_barrier()
#define PG8_SCHED __builtin_amdgcn_sched_barrier(0)
    Unit cur, nxt; int ui = 0;
    if (!S.next(0, cur)) return;
    f32x4 acc[2][2][4][2];
#pragma unroll
    for (int a = 0; a < 2; ++a)
#pragma unroll
        for (int b = 0; b < 2; ++b)
#pragma unroll
            for (int m = 0; m < 4; ++m)
#pragma unroll
                for (int n = 0; n < 2; ++n) acc[a][b][m][n] = (f32x4){0.f, 0.f, 0.f, 0.f};
    bf16x8 At[4][2], B0[2][2], B1[2][2];
    const char* cA = (const char*)g.A + (size_t)cur.pm * tstep; const char* cB = (const char*)g.Bt + (size_t)cur.pn * tstep;
    S.a_ready(cur);
    if constexpr (SP2) {
        PG8_STAGE(PG8_SB(0, 0), cB, voffB); PG8_STAGE(PG8_SB(0, 1), cB + hstep, voffB); PG8_STAGE(PG8_SA(0, 0), cA, voffA); PG8_STAGE(PG8_SA(0, 1), cA + hstep, voffA);
        if (wr == 1) PG8_BAR;
        PG8_WAIT_V(2); PG8_BAR;
        PG8_STAGE(PG8_SB(1, 0), cB + kstep, voffB); PG8_STAGE(PG8_SA(1, 0), cA + kstep, voffA); PG8_STAGE(PG8_SB(1, 1), cB + hstep + kstep, voffB);
        PG8_WAIT_V(6); PG8_BAR;
    } else {
        PG8_STAGE(PG8_SB(0, 0), cB, voffB); PG8_STAGE(PG8_SA(0, 0), cA, voffA); PG8_STAGE(PG8_SB(0, 1), cB + hstep, voffB); PG8_STAGE(PG8_SA(0, 1), cA + hstep, voffA);
        if (wr == 1) PG8_BAR;
        PG8_WAIT_V(4); PG8_BAR;
        PG8_STAGE(PG8_SB(1, 0), cB + kstep, voffB); PG8_STAGE(PG8_SA(1, 0), cA + kstep, voffA); PG8_STAGE(PG8_SB(1, 1), cB + hstep + kstep, voffB);
        PG8_WAIT_V(6); PG8_BAR;
    }
    for (;;) {
        const bool has_next = S.next(ui + 1, nxt);
        const char* nA = has_next ? (const char*)g.A + (size_t)nxt.pm * tstep : cA; const char* nB = has_next ? (const char*)g.Bt + (size_t)nxt.pn * tstep : cB;
        for (int t = 0; t < nt; t += 2) {
            const bool last = (t == nt - 2);
            const char* a1 = cA + (size_t)(t + 1) * kstep;
            const char* a2 = last ? nA : cA + (size_t)(t + 2) * kstep; const char* b2 = last ? nB : cB + (size_t)(t + 2) * kstep;
            const char* a3 = a2 + kstep; const char* b3 = b2 + kstep;
            if (last && has_next) S.a_ready(nxt);
            if constexpr (SP2) {
            PG8_LDB(B0, 0, 0); PG8_LDB(B1, 0, 1); PG8_SCHED; PG8_LDA(At, 0, 0); PG8_STAGE(PG8_SA(1, 1), a1 + hstep, voffA);
            PG8_WAIT_V(8); PG8_WAIT_L(0); PG8_BAR; PG8_MMA(0, 0, At, B0); PG8_MMA(0, 1, At, B1); PG8_BAR; PG8_SCHED;
            PG8_LDA(At, 0, 1); PG8_STAGE(PG8_SB(0, 0), b2, voffB); PG8_STAGE(PG8_SB(0, 1), b2 + hstep, voffB); PG8_STAGE(PG8_SA(0, 0), a2, voffA);
            PG8_WAIT_V(8); PG8_WAIT_L(0); PG8_BAR; PG8_MMA(1, 0, At, B0); PG8_MMA(1, 1, At, B1); PG8_BAR; PG8_SCHED;
            PG8_LDB(B0, 1, 0); PG8_LDB(B1, 1, 1); PG8_SCHED; PG8_LDA(At, 1, 0); PG8_STAGE(PG8_SA(0, 1), a2 + hstep, voffA);
            PG8_WAIT_V(8); PG8_WAIT_L(0); PG8_BAR; PG8_MMA(0, 0, At, B0); PG8_MMA(0, 1, At, B1); PG8_BAR; PG8_SCHED;
            PG8_LDA(At, 1, 1); PG8_STAGE(PG8_SB(1, 0), b3, voffB); PG8_STAGE(PG8_SB(1, 1), b3 + hstep, voffB); PG8_STAGE(PG8_SA(1, 0), a3, voffA);
            PG8_WAIT_V(8); PG8_WAIT_L(0); PG8_BAR; PG8_MMA(1, 0, At, B0); PG8_MMA(1, 1, At, B1); PG8_BAR; PG8_SCHED;
            } else {
            PG8_LDB(B0, 0, 0); PG8_SCHED; PG8_LDA(At, 0, 0); PG8_STAGE(PG8_SA(1, 1), a1 + hstep, voffA);
            PG8_WAIT_L(8); PG8_BAR; PG8_WAIT_L(0); PG8_MMA(0, 0, At, B0); PG8_BAR; PG8_SCHED;
            PG8_LDB(B1, 0, 1); PG8_STAGE(PG8_SB(0, 0), b2, voffB);
            PG8_BAR; PG8_WAIT_L(0); PG8_MMA(0, 1, At, B1); PG8_BAR;
            PG8_LDA(At, 0, 1); PG8_STAGE(PG8_SA(0, 0), a2, voffA);
            PG8_BAR; PG8_WAIT_L(0); PG8_MMA(1, 0, At, B0); PG8_BAR; PG8_SCHED;
            PG8_STAGE(PG8_SB(0, 1), b2 + hstep, voffB);
            PG8_WAIT_V(6); PG8_BAR; PG8_MMA(1, 1, At, B1); PG8_BAR;
            PG8_LDB(B0, 1, 0); PG8_SCHED; PG8_LDA(At, 1, 0); PG8_STAGE(PG8_SA(0, 1), a2 + hstep, voffA);
            PG8_WAIT_L(8); PG8_BAR; PG8_WAIT_L(0); PG8_MMA(0, 0, At, B0); PG8_BAR; PG8_SCHED;
            PG8_LDB(B1, 1, 1); PG8_STAGE(PG8_SB(1, 0), b3, voffB);
            PG8_BAR; PG8_WAIT_L(0); PG8_MMA(0, 1, At, B1); PG8_BAR;
            PG8_LDA(At, 1, 1); PG8_STAGE(PG8_SA(1, 0), a3, voffA);
            PG8_BAR; PG8_WAIT_L(0); PG8_MMA(1, 0, At, B0); PG8_BAR; PG8_SCHED;
            PG8_STAGE(PG8_SB(1, 1), b3 + hstep, voffB);
            PG8_WAIT_V(6); PG8_BAR; PG8_MMA(1, 1, At, B1); PG8_BAR;
            }
        }
        if constexpr (ALIGN_EPI) { if (wr == 0) PG8_BAR; }
        if constexpr (!Epi::AFTER_DRAIN) { E(acc, cur, wr, wc, fr, fq); S.done(cur); }
        if (!has_next) break;
#pragma unroll
        for (int a = 0; a < 2; ++a)
#pragma unroll
            for (int b = 0; b < 2; ++b)
#pragma unroll
                for (int m = 0; m < 4; ++m)
#pragma unroll
                    for (int n = 0; n < 2; ++n) acc[a][b][m][n] = (f32x4){0.f, 0.f, 0.f, 0.f};
        cur = nxt; cA = nA; cB = nB; ++ui;
        if constexpr (ALIGN_EPI) { if (wr == 1) PG8_BAR; }
    }
    PG8_WAIT_V(0);
    if constexpr (!ALIGN_EPI) { if (wr == 0) PG8_BAR; }
    PG8_BAR;
    if constexpr (Epi::AFTER_DRAIN) { E.fused(acc, cur, wr, wc, fr, fq, lds, wid, lane); S.done(cur); }
#undef PG8_SA
#undef PG8_SB
#undef PG8_STAGE
#undef PG8_LDA
#undef PG8_LDB
#undef PG8_MMA
#undef PG8_WAIT_V
#undef PG8_WAIT_L
#undef PG8_BAR
#undef PG8_SCHED
}
}

constexpr int NWAVES = 8;
constexpr int D = 1024, NB = 8, TP = 2064, MP = NB * TP  , NS = 128, TS = 4, MS = NS * TS, MREAL = MP + MS  , MPAD = 17152  ;
constexpr int DEPTH = 4, HGW = 512, NPROJ = 4096, DFF = 2816, NAB = 2 * DFF, SEQP = 2048, NMETA = 16;
constexpr int NPOS = TP + TS;
constexpr float LN_EPS = 1e-5f, F_EPS = 1e-6f;
constexpr float ALPHA = 1.6817928305074290f;
constexpr float RT_KSCALE = 0.08838834764831845f;

constexpr size_t MiB = 1u << 20;
constexpr size_t WS_CTL = 0, CTL_ZERO_BYTES = 2 * MiB;
constexpr size_t CTL_STATS = 256 * 1024;
constexpr size_t CTL_GW = 1536 * 1024;
constexpr int GW_PER_LAYER = 2 * NPROJ + 2 * NAB;
static_assert(CTL_STATS + 9 * (size_t)MPAD * 8 <= CTL_GW && CTL_GW + (size_t)DEPTH * GW_PER_LAYER * 4 <= CTL_ZERO_BYTES, "ctl map");
constexpr size_t WS_SMALL = 2 * MiB;
constexpr size_t SM_LB = 0, SM_ONES = 8192, SM_ROPE = 16384;
static_assert(SM_ROPE + (size_t)NPOS * 64 * 8 <= 2 * MiB, "small map");
constexpr size_t WS_W = 4 * MiB;
constexpr size_t W_LAYER = (size_t)(NPROJ + D + NAB) * D * 2 + (size_t)D * DFF * 2;
constexpr size_t W_IN = 0, W_O = (size_t)NPROJ * D * 2, W_AB = W_O + (size_t)D * D * 2, W_DN = W_AB + (size_t)NAB * D * 2;
constexpr size_t WS_Y = 112 * MiB, WS_Y1 = 179 * MiB, WS_YB = 246 * MiB, WS_R = 280 * MiB;
static_assert(WS_W + DEPTH * W_LAYER <= WS_Y && (size_t)MPAD * D * 4 == 67 * MiB, "weights/y map");
constexpr size_t ACT = (size_t)MPAD * D * 2;
constexpr size_t R_QT = 0, R_KT = ACT, R_VR = 2 * ACT, R_GT = 3 * ACT, R_O = 4 * ACT, R_KTT = 5 * ACT, R_VTT = 6 * ACT, R_DEC = 7 * ACT, R_DECS = R_DEC + (size_t)(MPAD / 16) * HGW * 4;
constexpr size_t R_A = 0, R_G = (size_t)MPAD * DFF * 2;
constexpr size_t WS_END = WS_R + 240 * MiB;
static_assert(R_DECS + (size_t)NS * HGW * 4 <= 240 * MiB && R_G * 2 <= R_O + 0 * ACT + 240 * MiB, "region map");
static_assert(R_G * 2 <= 240 * MiB, "ffn overlay");

constexpr int CW_BAR = 4096;

constexpr int RING_BYTES = 131072, LDSCTL_OFF = RING_BYTES, MISC_OFF = LDSCTL_OFF + 320, LDS_BYTES = 147456;

#define GAS __attribute__((address_space(1)))
#define LAS __attribute__((address_space(3)))
typedef unsigned short bf16;
typedef unsigned v4u __attribute__((ext_vector_type(4)));
typedef unsigned v2u __attribute__((ext_vector_type(2)));
typedef float f32x4 __attribute__((ext_vector_type(4)));
typedef float f32x2 __attribute__((ext_vector_type(2)));
#define LDS_WAIT() asm volatile("s_waitcnt lgkmcnt(0)" ::: "memory")
#define VM_WAIT() asm volatile("s_waitcnt vmcnt(0)" ::: "memory")
__device__ __forceinline__ unsigned f2bf(float f) { unsigned u = __builtin_bit_cast(unsigned, f); return (u + 0x7fffu + ((u >> 16) & 1u)) >> 16; }
__device__ __forceinline__ float bf2f(unsigned h) { return __builtin_bit_cast(float, h << 16); }
__device__ __forceinline__ float bflo(unsigned w) { return __builtin_bit_cast(float, w << 16); }
__device__ __forceinline__ float bfhi(unsigned w) { return __builtin_bit_cast(float, w & 0xffff0000u); }
__device__ __forceinline__ unsigned pk2(float lo, float hi) { return pg8::cvt_pk_bf16(lo, hi); }
__device__ __forceinline__ float sigmoidf_(float x) { return 1.0f / (1.0f + __expf(-x)); }

#define XB_TMO      128
#define XB_XCNT(j)  (256  + 64 * (j))
#define XB_XSUB(j)  (1280 + 64 * (j))
#define XB_XGEN(j)  (2304 + 64 * (j))
#define XB_TOP      3328
#define XB_TOPGEN   3392
#define XCD_BAR_WORDS 3456
#define XB_SPIN_CAP (1u << 18)

__device__ __forceinline__ unsigned xb_ld(unsigned* p)              { return __hip_atomic_load(p, __ATOMIC_RELAXED, __HIP_MEMORY_SCOPE_AGENT); }
__device__ __forceinline__ unsigned xb_add(unsigned* p, unsigned v) { return __hip_atomic_fetch_add(p, v, __ATOMIC_RELAXED, __HIP_MEMORY_SCOPE_AGENT); }
__device__ __forceinline__ unsigned xb_xcc_id() { return (unsigned)__builtin_amdgcn_s_getreg((3 << 11) | 20) & 0xFu; }
#define XB_SPIN(cond, bar) do { unsigned _sp = 0; while (cond) { __builtin_amdgcn_s_sleep(1); \
    if ((++_sp & 255u) == 0u) { if (xb_ld(&(bar)[XB_TMO])) break; if (_sp > XB_SPIN_CAP) { atomicAdd(&(bar)[XB_TMO], 1u); break; } } } } while (0)

struct XcdBarrier {
    unsigned* bar; unsigned x;
    volatile LAS unsigned* st;
};

__device__ __forceinline__ XcdBarrier xcd_barrier_post(unsigned* bar, volatile LAS unsigned* st) {
    XcdBarrier b; b.bar = bar; b.x = xb_xcc_id(); b.st = st;
    if (threadIdx.x == 0) (void)xb_add(&bar[XB_XCNT(b.x)], 1u);
    return b;
}
__device__ __forceinline__ void xcd_barrier_complete(unsigned* bar, unsigned x, unsigned& nloc, unsigned& nx) {
    const unsigned G = gridDim.x * gridDim.y * gridDim.z;
    unsigned sum, cnt, mine, sp = 0u;
    for (;;) {
        sum = 0u; cnt = 0u; mine = 0u;
#pragma unroll
        for (unsigned j = 0; j < 16; ++j) { const unsigned c = xb_ld(&bar[XB_XCNT(j)]); sum += c; cnt += (c > 0u) ? 1u : 0u; mine = (j == x) ? c : mine; }
        if (sum == G) break;
        __builtin_amdgcn_s_sleep(1);
        if ((++sp & 255u) == 0u) { if (xb_ld(&bar[XB_TMO])) break; if (sp > XB_SPIN_CAP) { atomicAdd(&bar[XB_TMO], 1u); break; } }
    }
    nloc = mine > 0u ? mine : 1u; nx = cnt > 0u ? cnt : 1u;
}

__device__ __forceinline__ void xcd_barrier(const XcdBarrier& b) {
    asm volatile("s_waitcnt vmcnt(0)" ::: "memory");
    __syncthreads();
    if (threadIdx.x == 0) {
        unsigned* bar = b.bar;
        __builtin_amdgcn_s_waitcnt(0);
        unsigned nloc = b.st[0], nx = b.st[1];
        if (nloc == 0u) { xcd_barrier_complete(bar, b.x, nloc, nx); b.st[0] = nloc; b.st[1] = nx; }
        const unsigned old = xb_add(&bar[XB_XSUB(b.x)], 1u);
        const unsigned gen = old / nloc;
        if (old + 1u == (gen + 1u) * nloc) {
            __builtin_amdgcn_fence(__ATOMIC_RELEASE, "agent");
            asm volatile("s_waitcnt vmcnt(0)" ::: "memory");
            const unsigned og = xb_add(&bar[XB_TOP], 1u);
            const unsigned tg = og / nx;
            if (og + 1u == (tg + 1u) * nx) xb_add(&bar[XB_TOPGEN], 1u);
            else XB_SPIN(xb_ld(&bar[XB_TOPGEN]) == tg, bar);
            __builtin_amdgcn_fence(__ATOMIC_ACQUIRE, "agent");
            xb_add(&bar[XB_XGEN(b.x)], 1u);
            asm volatile("s_waitcnt vmcnt(0)" ::: "memory");
        } else {
            XB_SPIN(xb_ld(&bar[XB_XGEN(b.x)]) == gen, bar);
            __builtin_amdgcn_fence(__ATOMIC_ACQUIRE, "agent");
            asm volatile("s_waitcnt vmcnt(0)" ::: "memory");
        }
    }
    __syncthreads();
}


struct Frame {
    LAS unsigned char* lds;
    int tid, lane, wave;
    const float* const* in;
    float* out; unsigned char* ws;
};
enum { I_XP = 0, I_XS, I_SHG, I_SRT, I_SCV, I_META, I_EG, I_EB, I_LBL, I_WIN, I_HGN, I_GNG, I_GNB, I_WO, I_L1G, I_L1B, I_WA, I_WB, I_CW, I_CB, I_WD, I_L2G, I_L2B };
constexpr size_t O_YP = 0, O_YS = O_YP + (size_t)NB * SEQP * D, O_HP = O_YS + (size_t)NS * TS * D, O_HS = O_HP + (size_t)DEPTH * NB * 4 * 16384,
                 O_RP = O_HS + (size_t)DEPTH * NS * 4 * 16384, O_RS = O_RP + (size_t)DEPTH * NB * 4 * 16384, O_CP = O_RS + (size_t)DEPTH * NS * 4 * 16384,
                 O_CS = O_CP + (size_t)DEPTH * NB * 2 * DFF, O_END = O_CS + (size_t)DEPTH * NS * 2 * DFF;
static_assert(O_END == 91668480, "output size");

__device__ __forceinline__ f32x2* stats_ptr(unsigned char* ws, int idx) { return (f32x2*)(ws + WS_CTL + CTL_STATS) + (size_t)idx * MPAD; }
__device__ __forceinline__ float* gw_ptr(unsigned char* ws, int l, int which) {
    float* p = (float*)(ws + WS_CTL + CTL_GW) + (size_t)l * GW_PER_LAYER;
    return which == 0 ? p : which == 1 ? p + NPROJ : which == 2 ? p + 2 * NPROJ : p + 2 * NPROJ + NAB;
}
__device__ __forceinline__ bf16* w_ptr(unsigned char* ws, int l, size_t off) { return (bf16*)(ws + WS_W + (size_t)l * W_LAYER + off); }

__device__ __forceinline__ float wave_sum(float v) {
#pragma unroll
    for (int o = 1; o < 64; o <<= 1) v += __shfl_xor(v, o);
    return v;
}

__device__ __forceinline__ float rt_log_gamma(int h) { return h == 0 ? -0.031748698314580298f : h == 1 ? -0.015748356968139168f : h == 2 ? -0.007843177461025892f : -0.003913899321136329f; }
__device__ __forceinline__ int win_src_col(int np) {
    const int tile = np >> 8, j = np & 255, bj = j >> 7, jj = j & 127;
    if (tile < 4) return bj == 0 ? 128 * tile + jj : 512 + 128 * tile + jj;
    if (tile < 6) return 1024 + 256 * (tile - 4) + j;
    if (tile < 8) return 1536 + 256 * (tile - 6) + j;
    if (tile < 12) { const int base = tile < 10 ? 2048 : 2560, hd = 2 * (tile & 1) + (jj >> 6), i = jj & 63; return base + 128 * hd + 64 * bj + i; }
    if (tile < 14) return 3072 + 256 * (tile - 12) + j;
    return 3584 + 256 * (tile - 14) + j;
}
__device__ __forceinline__ float rope_inv(int i) {
    static const float T[64] = {1.0f, 0.865964353f, 0.749894202f, 0.649381638f, 0.562341332f, 0.486967534f, 0.421696514f, 0.365174115f, 0.316227764f, 0.273841977f, 0.237137377f, 0.2053525f, 0.177827939f, 0.153992653f, 0.133352146f, 0.115478195f, 0.100000001f, 0.0865964293f, 0.0749894232f, 0.0649381652f, 0.0562341325f, 0.0486967526f, 0.0421696492f, 0.0365174115f, 0.0316227749f, 0.0273841955f, 0.0237137377f, 0.0205352511f, 0.0177827943f, 0.0153992651f, 0.013335214f, 0.0115478197f, 0.00999999978f, 0.00865964312f, 0.00749894232f, 0.00649381615f, 0.00562341325f, 0.00486967526f, 0.00421696482f, 0.00365174119f, 0.00316227763f, 0.00273841969f, 0.00237137382f, 0.00205352507f, 0.00177827943f, 0.00153992651f, 0.00133352145f, 0.00115478202f, 0.00100000005f, 0.000865964335f, 0.000749894185f, 0.000649381604f, 0.000562341302f, 0.000486967532f, 0.000421696517f, 0.000365174114f, 0.000316227757f, 0.000273841957f, 0.00023713737f, 0.00020535251f, 0.00017782794f, 0.00015399266f, 0.00013335215f, 0.0001154782f};
    return T[i];
}
__device__ __forceinline__ void tr_item(const float* W, int Nsrc, int scol, const float* gv, const float* bv, bf16* WT, int K, int n0, float* gW, float* bW, LAS float* scr, int k0, int lane) {
    float bacc = 0.f;
#pragma unroll 8
    for (int i = 0; i < 32; ++i) { const int kk = 2 * i + (lane >> 5); float w = W[(size_t)(k0 + kk) * Nsrc + scol];
        if (gv) { bacc += w * bv[k0 + kk]; w *= gv[k0 + kk]; }
        scr[kk * 33 + (lane & 31)] = w; }
    LDS_WAIT(); asm volatile("" ::: "memory");
    const int c = lane & 7;
#pragma unroll
    for (int j = 0; j < 4; ++j) { const int n = (lane >> 3) + 8 * j; const LAS float* s = scr + (8 * c) * 33 + n;
        unsigned h[8]; float gs = 0.f;
#pragma unroll
        for (int e = 0; e < 8; ++e) { h[e] = f2bf(s[e * 33]); gs += bf2f(h[e]); }
        v4u o; o.x = h[0] | (h[1] << 16); o.y = h[2] | (h[3] << 16); o.z = h[4] | (h[5] << 16); o.w = h[6] | (h[7] << 16);
        *(v4u*)(WT + (size_t)(n0 + n) * K + k0 + 8 * c) = o;
        if (gv) { gs += __shfl_xor(gs, 1); gs += __shfl_xor(gs, 2); gs += __shfl_xor(gs, 4); if (c == 0) atomicAdd(gW + n0 + n, gs); } }
    if (gv) { bacc += __shfl_xor(bacc, 32); if (lane < 32) atomicAdd(bW + n0 + lane, bacc); }
    LDS_WAIT(); asm volatile("" ::: "memory");
}
__device__ __forceinline__ void p0_prologue(Frame& F) {
    unsigned char* ws = F.ws;
    LAS float* scr = (LAS float*)(F.lds + F.wave * 16384);
    const int gw = blockIdx.x * NWAVES + F.wave, NGW = gridDim.x * NWAVES, lane = F.lane;
    const int gtid = blockIdx.x * (NWAVES * 64) + F.tid, NT = gridDim.x * NWAVES * 64;
    constexpr int I_IN = 16 * 128, I_O = 16 * 32, I_AB = 16 * 176, I_D = 44 * 32, I_L = I_IN + I_O + I_AB + I_D;
    for (int it = gw; it < DEPTH * I_L; it += NGW) {
        const int l = it / I_L; int r = it - l * I_L;
        if (r < I_IN) { const int kb = r / 128, nb = r % 128, n0 = 32 * nb;
            const float* gv = l ? F.in[I_L2G] + (l - 1) * D : nullptr; const float* bv = l ? F.in[I_L2B] + (l - 1) * D : nullptr;
            tr_item(F.in[I_WIN] + (size_t)l * D * NPROJ, NPROJ, win_src_col(n0 + (lane & 31)), gv, bv, w_ptr(ws, l, W_IN), D, n0, gw_ptr(ws, l, 0), gw_ptr(ws, l, 1), scr, 64 * kb, lane); continue; }
        r -= I_IN;
        if (r < I_O) { const int kb = r / 32, nb = r % 32, n0 = 32 * nb;
            tr_item(F.in[I_WO] + (size_t)l * D * D, D, n0 + (lane & 31), nullptr, nullptr, w_ptr(ws, l, W_O), D, n0, nullptr, nullptr, scr, 64 * kb, lane); continue; }
        r -= I_O;
        if (r < I_AB) { const int kb = r / 176, nb = r % 176, n0 = 32 * nb, tile = n0 >> 8, bj = (n0 >> 7) & 1, jj = (n0 & 127) + (lane & 31);
            const float* W = (bj ? F.in[I_WB] : F.in[I_WA]) + (size_t)l * D * DFF;
            tr_item(W, DFF, 128 * tile + jj, F.in[I_L1G] + l * D, F.in[I_L1B] + l * D, w_ptr(ws, l, W_AB), D, n0, gw_ptr(ws, l, 2), gw_ptr(ws, l, 3), scr, 64 * kb, lane); continue; }
        r -= I_AB;
        { const int kb = r / 32, nb = r % 32, n0 = 32 * nb;
            tr_item(F.in[I_WD] + (size_t)l * DFF * D, D, n0 + (lane & 31), nullptr, nullptr, w_ptr(ws, l, W_DN), DFF, n0, nullptr, nullptr, scr, 64 * kb, lane); }
    }
    float* lb = (float*)(ws + WS_SMALL + SM_LB);
    if (gtid < HGW) { const float* L = F.in[I_LBL]; const float a0 = L[gtid], a1 = L[HGW + gtid], a2 = L[2 * HGW + gtid], a3 = L[3 * HGW + gtid];
        const float mx = fmaxf(fmaxf(a0, a1), fmaxf(a2, a3)); const float e0 = expf(a0 - mx), e1 = expf(a1 - mx), e2 = expf(a2 - mx), e3 = expf(a3 - mx), inv = 1.0f / (e0 + e1 + e2 + e3);
        lb[gtid] = 0.f; lb[HGW + gtid] = e1 * inv; lb[2 * HGW + gtid] = (e1 + e2) * inv; lb[3 * HGW + gtid] = (e1 + e2 + e3) * inv; }
    if (gtid >= 1024 && gtid < 2048) ((float*)(ws + WS_SMALL + SM_ONES))[gtid - 1024] = 1.0f;
    { f32x2* st = stats_ptr(ws, 0); for (int r = gtid; r < MPAD; r += NT) st[r] = (f32x2){0.f, 1024.0f * (1.0f - LN_EPS)}; }
    { f32x2* rope = (f32x2*)(ws + WS_SMALL + SM_ROPE);
      for (int e = gtid; e < NPOS * 64; e += NT) { const int pi = e >> 6, i = e & 63; const int pos = pi < TP ? pi : 16384 + (pi - TP);
          const float ang = (float)pos * rope_inv(i);
          double q = (double)ang * 0.15915494309189535; q -= __builtin_rint(q);
          const float fr = (float)q;
          rope[e] = (f32x2){__builtin_amdgcn_cosf(fr), __builtin_amdgcn_sinf(fr)}; } }
    float* Y = (float*)(ws + WS_Y); bf16* YB = (bf16*)(ws + WS_YB);
    const float* eg = F.in[I_EG]; const float* eb = F.in[I_EB];
    for (int row = gw; row < MPAD; row += NGW) {
        f32x4* yo = (f32x4*)(Y + (size_t)row * D) + lane; v2u* bo = (v2u*)(YB + (size_t)row * D) + lane;
        if (row >= MREAL) {
#pragma unroll
            for (int j = 0; j < 4; ++j) { yo[64 * j] = (f32x4){0.f, 0.f, 0.f, 0.f}; bo[64 * j] = (v2u){0u, 0u}; }
            continue; }
        const float* src;
        if (row < MP) { const int b = row / TP, t = row - b * TP; src = t < NMETA ? F.in[I_META] + (size_t)t * D : F.in[I_XP] + ((size_t)b * SEQP + (t - NMETA)) * D; }
        else src = F.in[I_XS] + (size_t)(row - MP) * D;
        const f32x4* xr = (const f32x4*)src + lane;
        f32x4 v[4]; float s = 0.f;
#pragma unroll
        for (int j = 0; j < 4; ++j) { v[j] = xr[64 * j]; s += (v[j].x + v[j].y) + (v[j].z + v[j].w); }
        const float mean = wave_sum(s) * (1.f / D); float s2 = 0.f;
#pragma unroll
        for (int j = 0; j < 4; ++j) { v[j] = v[j] - mean; s2 += (v[j].x * v[j].x + v[j].y * v[j].y) + (v[j].z * v[j].z + v[j].w * v[j].w); }
        const float rstd = 1.f / sqrtf(wave_sum(s2) * (1.f / D) + LN_EPS);
#pragma unroll
        for (int j = 0; j < 4; ++j) { const f32x4 g = ((const f32x4*)eg)[lane + 64 * j], b = ((const f32x4*)eb)[lane + 64 * j]; const f32x4 y = v[j] * rstd * g + b;
            yo[64 * j] = y; bo[64 * j] = (v2u){pk2(y.x, y.y), pk2(y.z, y.w)}; }
    }
}

using pg8::Unit;
struct EpiIn {
    static constexpr bool PERM = true, AFTER_DRAIN = false;
    const f32x2* st; const float* gW; const float* bW; const float* lb; const f32x2* rope;
    bf16* QT; bf16* KT; bf16* VR; bf16* GT; float* DEC; float* DECS;
    template <int TYPE>
    __device__ __forceinline__ void run(const f32x4 (&acc)[2][2][4][2], const Unit& u, int wr, int wc, int fr, int fq) const {
        const int pn = u.pn, jj0 = wc * 32 + 8 * fq;
        f32x4 lbv[2] = {(f32x4){0.f, 0.f, 0.f, 0.f}, (f32x4){0.f, 0.f, 0.f, 0.f}};
        if (TYPE == 0) { lbv[0] = *(const f32x4*)(lb + 128 * pn + jj0); lbv[1] = *(const f32x4*)(lb + 128 * pn + jj0 + 4); }
        const int hd = 2 * (pn & 1) + (jj0 >> 6), i0 = jj0 & 63;
        const float lg = rt_log_gamma(hd);
        const int cb12 = ((pn & 8) ? 512 : 0) + 256 * (pn & 1);
#pragma unroll
        for (int ai = 0; ai < 2; ++ai) {
            const int rowbase = u.pm * 256 + ai * 128 + wr * 64;
            const bool smp = rowbase >= MP;
            const int tau = smp ? (fr & 3) : fr;
#pragma unroll
            for (int m = 0; m < 4; ++m) {
                const int row = rowbase + 16 * m + fr;
                const f32x2 s = st[row]; const float mu = s.x * (1.f / D), rstd = rsqrtf(s.y * (1.f / D) - mu * mu + LN_EPS);
                f32x4 v[2][2];
#pragma unroll
                for (int bj = 0; bj < 2; ++bj)
#pragma unroll
                    for (int n = 0; n < 2; ++n) { const f32x4 gwv = *(const f32x4*)(gW + 256 * pn + 128 * bj + jj0 + 4 * n), bwv = *(const f32x4*)(bW + 256 * pn + 128 * bj + jj0 + 4 * n);
                        v[bj][n] = (acc[ai][bj][m][n] - mu * gwv) * rstd + bwv; }
                if (TYPE == 0) {
                    float qt[8], kt[8], bb[8];
#pragma unroll
                    for (int n = 0; n < 2; ++n)
#pragma unroll
                        for (int i = 0; i < 4; ++i) { const float hq = v[0][n][i], hf = v[1][n][i], l0 = lbv[n][i];
                            const float sg = sigmoidf_(hf), f = l0 + (1.f - l0) * sg; float b = __logf(fmaxf(f, F_EPS));
                            const float kk = (1.f - l0) * (1.f - sg), q = hq * sigmoidf_(hq);
                            { float y = __shfl_up(b, 1, 16); if (tau >= 1) b += y; y = __shfl_up(b, 2, 16); if (tau >= 2) b += y;
                              if (!smp) { y = __shfl_up(b, 4, 16); if (tau >= 4) b += y; y = __shfl_up(b, 8, 16); if (tau >= 8) b += y; } }
                            bb[4 * n + i] = b; qt[4 * n + i] = q * __expf(b); kt[4 * n + i] = kk * __expf(-b); }
                    const size_t o = (size_t)row * D + 128 * pn + jj0;
                    *(v4u*)(QT + o) = (v4u){pk2(qt[0], qt[1]), pk2(qt[2], qt[3]), pk2(qt[4], qt[5]), pk2(qt[6], qt[7])};
                    *(v4u*)(KT + o) = (v4u){pk2(kt[0], kt[1]), pk2(kt[2], kt[3]), pk2(kt[4], kt[5]), pk2(kt[6], kt[7])};
                    if (!smp) { if (fr == 15) { float* d = DEC + (size_t)(row >> 4) * HGW + 128 * pn + jj0; *(f32x4*)d = (f32x4){bb[0], bb[1], bb[2], bb[3]}; *(f32x4*)(d + 4) = (f32x4){bb[4], bb[5], bb[6], bb[7]}; } }
                    else if ((fr & 3) == 3) { float* d = DECS + (size_t)((row - MP) >> 2) * HGW + 128 * pn + jj0; *(f32x4*)d = (f32x4){bb[0], bb[1], bb[2], bb[3]}; *(f32x4*)(d + 4) = (f32x4){bb[4], bb[5], bb[6], bb[7]}; }
                } else if (TYPE == 1 || TYPE == 2) {
                    bf16* dst = (TYPE == 1 ? VR : GT) + (size_t)row * D + cb12 + jj0;
#pragma unroll
                    for (int bj = 0; bj < 2; ++bj) { f32x4 a = v[bj][0], b = v[bj][1];
                        if (TYPE == 2) {
#pragma unroll
                            for (int i = 0; i < 4; ++i) { a[i] = a[i] * sigmoidf_(a[i]); b[i] = b[i] * sigmoidf_(b[i]); } }
                        *(v4u*)(dst + 128 * bj) = (v4u){pk2(a[0], a[1]), pk2(a[2], a[3]), pk2(b[0], b[1]), pk2(b[2], b[3])}; }
                } else {
                    const int pi = smp ? TP + ((row - MP) & 3) : row - TP * (row / TP);
                    const f32x4* cs = (const f32x4*)(rope + (size_t)pi * 64 + i0);
                    const float sc = TYPE == 3 ? __expf((float)(tau + 1) * lg) : RT_KSCALE * __expf(-(float)(tau + 1) * lg);
                    float o1[8], o2[8];
#pragma unroll
                    for (int p = 0; p < 4; ++p) { const f32x4 c2 = cs[p];
#pragma unroll
                        for (int e = 0; e < 2; ++e) { const int j = 2 * p + e; const float c = c2[2 * e], sn = c2[2 * e + 1], x1 = v[0][j >> 2][j & 3], x2 = v[1][j >> 2][j & 3];
                            o1[j] = (x1 * c - x2 * sn) * sc; o2[j] = (x1 * sn + x2 * c) * sc; } }
                    bf16* dst = (TYPE == 3 ? QT : KT) + (size_t)row * D + HGW + 128 * hd + i0;
                    *(v4u*)dst = (v4u){pk2(o1[0], o1[1]), pk2(o1[2], o1[3]), pk2(o1[4], o1[5]), pk2(o1[6], o1[7])};
                    *(v4u*)(dst + 64) = (v4u){pk2(o2[0], o2[1]), pk2(o2[2], o2[3]), pk2(o2[4], o2[5]), pk2(o2[6], o2[7])};
                }
                asm volatile("" ::: "memory");
            }
        }
    }
    __device__ __forceinline__ void operator()(const f32x4 (&acc)[2][2][4][2], const Unit& u, int wr, int wc, int fr, int fq) const {
        const int pn = u.pn;
        if (pn < 4) run<0>(acc, u, wr, wc, fr, fq);
        else if (pn == 4 || pn == 5 || pn == 12 || pn == 13) run<1>(acc, u, wr, wc, fr, fq);
        else if (pn == 6 || pn == 7 || pn >= 14) run<2>(acc, u, wr, wc, fr, fq);
        else if (pn < 10) run<3>(acc, u, wr, wc, fr, fq);
        else run<4>(acc, u, wr, wc, fr, fq);
    }
};
struct EpiRes {
    static constexpr bool PERM = false, AFTER_DRAIN = false;
    const float* Yin; float* Yout; bf16* YB; const f32x2* st_in; const float* g; const float* b; f32x2* st_out;
    __device__ __forceinline__ void operator()(const f32x4 (&acc)[2][2][4][2], const Unit& u, int wr, int wc, int fr, int fq) const {
        const int col0 = u.pn * 256 + wc * 32 + 4 * fq;
        f32x4 gv[2][2], bv[2][2];
#pragma unroll
        for (int bj = 0; bj < 2; ++bj)
#pragma unroll
            for (int n = 0; n < 2; ++n) { gv[bj][n] = *(const f32x4*)(g + col0 + 128 * bj + 16 * n); bv[bj][n] = *(const f32x4*)(b + col0 + 128 * bj + 16 * n); }
#pragma unroll
        for (int ai = 0; ai < 2; ++ai)
#pragma unroll
            for (int m = 0; m < 4; ++m) {
                const int row = u.pm * 256 + ai * 128 + wr * 64 + 16 * m + fr;
                const f32x2 s = st_in[row]; const float mu = s.x * (1.f / D), rstd = rsqrtf(s.y * (1.f / D) - mu * mu + LN_EPS);
                const size_t off = (size_t)row * D + col0; float sy = 0.f, sq = 0.f;
#pragma unroll
                for (int bj = 0; bj < 2; ++bj)
#pragma unroll
                    for (int n = 0; n < 2; ++n) { const f32x4 yi = *(const f32x4*)(Yin + off + 128 * bj + 16 * n);
                        const f32x4 x = (yi - mu) * rstd * gv[bj][n] + bv[bj][n]; const f32x4 y = ALPHA * x + acc[ai][bj][m][n];
                        *(f32x4*)(Yout + off + 128 * bj + 16 * n) = y; *(v2u*)(YB + off + 128 * bj + 16 * n) = (v2u){pk2(y[0], y[1]), pk2(y[2], y[3])};
                        sy += (y[0] + y[1]) + (y[2] + y[3]); sq += (y[0] * y[0] + y[1] * y[1]) + (y[2] * y[2] + y[3] * y[3]); }
                sy += __shfl_xor(sy, 16); sy += __shfl_xor(sy, 32); sq += __shfl_xor(sq, 16); sq += __shfl_xor(sq, 32);
                if (fq == 0) { float* so = (float*)(st_out + row); atomicAdd(so, sy); atomicAdd(so + 1, sq); }
                if (m & 1) asm volatile("" ::: "memory");
            }
    }
};
struct EpiUp {
    static constexpr bool PERM = true, AFTER_DRAIN = false;
    const f32x2* st; const float* gW; const float* bW; bf16* A; bf16* G;
    __device__ __forceinline__ void operator()(const f32x4 (&acc)[2][2][4][2], const Unit& u, int wr, int wc, int fr, int fq) const {
        const int pn = u.pn, jj0 = wc * 32 + 8 * fq;
        f32x4 gw[2][2], bw[2][2];
#pragma unroll
        for (int bj = 0; bj < 2; ++bj)
#pragma unroll
            for (int n = 0; n < 2; ++n) { gw[bj][n] = *(const f32x4*)(gW + 256 * pn + 128 * bj + jj0 + 4 * n); bw[bj][n] = *(const f32x4*)(bW + 256 * pn + 128 * bj + jj0 + 4 * n); }
#pragma unroll
        for (int ai = 0; ai < 2; ++ai)
#pragma unroll
            for (int m = 0; m < 4; ++m) {
                const int row = u.pm * 256 + ai * 128 + wr * 64 + 16 * m + fr;
                const f32x2 s = st[row]; const float mu = s.x * (1.f / D), rstd = rsqrtf(s.y * (1.f / D) - mu * mu + LN_EPS);
                const size_t o = (size_t)row * DFF + 128 * pn + jj0;
#pragma unroll
                for (int bj = 0; bj < 2; ++bj) { const f32x4 a = (acc[ai][bj][m][0] - mu * gw[bj][0]) * rstd + bw[bj][0], b = (acc[ai][bj][m][1] - mu * gw[bj][1]) * rstd + bw[bj][1];
                    *(v4u*)((bj ? G : A) + o) = (v4u){pk2(a[0], a[1]), pk2(a[2], a[3]), pk2(b[0], b[1]), pk2(b[2], b[3])}; }
            }
    }
};

__device__ __forceinline__ void mixer_naive(Frame& F, int l) {
    unsigned char* ws = F.ws;
    const int tid = F.tid, v = tid & 127, kq = tid >> 7;
    LAS unsigned char* L = F.lds;
    LAS bf16* TL = (LAS bf16*)L;
    LAS float* Es = (LAS float*)(L + 16384);
    LAS float* OP = (LAS float*)(L + 16384 + 512);
    const bf16* QT = (const bf16*)(ws + WS_R + R_QT); const bf16* KT = (const bf16*)(ws + WS_R + R_KT); const bf16* VR = (const bf16*)(ws + WS_R + R_VR); const bf16* GT = (const bf16*)(ws + WS_R + R_GT);
    bf16* O = (bf16*)(ws + WS_R + R_O);
    const float* DEC = (const float*)(ws + WS_R + R_DEC); const float* DECS = (const float*)(ws + WS_R + R_DECS);
    const int w = blockIdx.x;
    for (int it = 0;; ++it) {
        bool smp; int seq, H, nchunks, ntok, row_base;
        if (w < 64) { if (it > 0) break; smp = false; seq = w >> 3; H = w & 7; nchunks = TP / 16; ntok = 16; row_base = seq * TP; }
        else { const int id = (w - 64) + (int)(gridDim.x - 64) * it; if (id >= NS * 8) break; smp = true; seq = id >> 3; H = id & 7; nchunks = 1; ntok = 4; row_base = MP + 4 * seq; }
        const bool hg = H < 4; const int h = H & 3;
        float Z[32];
        if (smp) { const float* S0 = (hg ? F.in[I_SHG] : F.in[I_SRT]) + (((size_t)l * NS + seq) * 4 + h) * 16384;
#pragma unroll
            for (int j = 0; j < 32; ++j) Z[j] = S0[(kq * 32 + j) * 128 + v]; }
        else {
#pragma unroll
            for (int j = 0; j < 32; ++j) Z[j] = 0.f; }
        const float lg = rt_log_gamma(h), Eret = __expf(lg * (float)ntok);
        const float* nrm_g = hg ? F.in[I_HGN] + l * HGW + 128 * h : F.in[I_GNG] + l * HGW + 128 * h;
        const float* nrm_b = F.in[I_GNB] + l * HGW + 128 * h;
        for (int c = 0; c < nchunks; ++c) {
            const int row0 = row_base + 16 * c;
            { const int tile = tid >> 7, p = tid & 127; const bf16* src = tile == 0 ? QT : tile == 1 ? KT : tile == 2 ? VR : GT;
#pragma unroll
              for (int rr = 0; rr < 2; ++rr) { const int r = (p >> 4) + 8 * rr; v4u x = (v4u){0u, 0u, 0u, 0u};
                  if (r < ntok) x = *(const v4u*)(src + (size_t)(row0 + r) * D + 128 * H + (p & 15) * 8);
                  *(LAS v4u*)(TL + tile * 2048 + r * 128 + (p & 15) * 8) = x; } }
            if (tid < 128) Es[tid] = hg ? __expf(smp ? DECS[(size_t)seq * HGW + 128 * h + tid] : DEC[(size_t)(row0 >> 4) * HGW + 128 * h + tid]) : Eret;
            __syncthreads();
            for (int t = 0; t < ntok; ++t) {
                const float vv = bf2f(TL[2 * 2048 + t * 128 + v]);
                float op = 0.f;
#pragma unroll
                for (int j4 = 0; j4 < 4; ++j4) { const v4u kw = *(const LAS v4u*)(TL + 2048 + t * 128 + kq * 32 + 8 * j4), qw = *(const LAS v4u*)(TL + t * 128 + kq * 32 + 8 * j4);
#pragma unroll
                    for (int e = 0; e < 4; ++e) { const unsigned ku = kw[e], qu = qw[e];
                        Z[8 * j4 + 2 * e] = fmaf(bflo(ku), vv, Z[8 * j4 + 2 * e]); op = fmaf(Z[8 * j4 + 2 * e], bflo(qu), op);
                        Z[8 * j4 + 2 * e + 1] = fmaf(bfhi(ku), vv, Z[8 * j4 + 2 * e + 1]); op = fmaf(Z[8 * j4 + 2 * e + 1], bfhi(qu), op); } }
                OP[(t * 4 + kq) * 128 + v] = op;
            }
            __syncthreads();
            { const int tt = tid >> 5, v4 = (tid & 31) * 4;
              f32x4 o = (f32x4){0.f, 0.f, 0.f, 0.f};
              if (tt < ntok) {
#pragma unroll
                  for (int q = 0; q < 4; ++q) o += *(const LAS f32x4*)(OP + (tt * 4 + q) * 128 + v4); }
              float s = (o[0] + o[1]) + (o[2] + o[3]), ss = (o[0] * o[0] + o[1] * o[1]) + (o[2] * o[2] + o[3] * o[3]);
#pragma unroll
              for (int x = 1; x < 32; x <<= 1) { s += __shfl_xor(s, x); ss += __shfl_xor(ss, x); }
              const v2u gwd = *(const LAS v2u*)(TL + 3 * 2048 + tt * 128 + v4);
              const float gt[4] = {bflo(gwd.x), bfhi(gwd.x), bflo(gwd.y), bfhi(gwd.y)};
              const f32x4 ng = *(const f32x4*)(nrm_g + v4);
              float r[4];
              if (hg) { const float rs = rsqrtf(ss * (1.f / 128.f) + LN_EPS);
#pragma unroll
                  for (int i = 0; i < 4; ++i) r[i] = o[i] * rs * ng[i] * gt[i]; }
              else { const f32x4 nb = *(const f32x4*)(nrm_b + v4); const float mean = s * (1.f / 128.f), rs = rsqrtf(ss * (1.f / 128.f) - mean * mean + LN_EPS);
#pragma unroll
                  for (int i = 0; i < 4; ++i) r[i] = ((o[i] - mean) * rs * ng[i] + nb[i]) * gt[i]; }
              if (tt < ntok) *(v2u*)(O + (size_t)(row0 + tt) * D + 128 * H + v4) = (v2u){pk2(r[0], r[1]), pk2(r[2], r[3])}; }
#pragma unroll
            for (int j = 0; j < 32; ++j) Z[j] *= Es[kq * 32 + j];
            __syncthreads();
        }
        float* dst = F.out + (smp ? (hg ? O_HS : O_RS) + (((size_t)l * NS + seq) * 4 + h) * 16384 : (hg ? O_HP : O_RP) + (((size_t)l * NB + seq) * 4 + h) * 16384);
#pragma unroll
        for (int j = 0; j < 32; ++j) dst[(kq * 32 + j) * 128 + v] = Z[j];
    }
}

typedef short bf16x8_t __attribute__((ext_vector_type(8)));
typedef short s16x4_t __attribute__((ext_vector_type(4)));
constexpr int MX_ROWB = 288;
constexpr int MX_TILE = 64 * MX_ROWB;
constexpr int MX_TQ = 0, MX_TK = MX_TILE, MX_TV = 2 * MX_TILE, MX_TG = 3 * MX_TILE  , MX_ES = 5 * MX_TILE, MX_PART = MX_ES + 4 * 128 * 4, MX_STAT = MX_PART + 64 * 8 * 8, MX_END = MX_STAT + 64 * 8;
static_assert(MX_END <= RING_BYTES, "mixer LDS");
__device__ __forceinline__ bf16x8_t mx_ld2(LAS unsigned char* p) { const v2u lo = *(const LAS v2u*)p, hi = *(const LAS v2u*)(p + 32); return __builtin_bit_cast(bf16x8_t, (v4u){lo.x, lo.y, hi.x, hi.y}); }
__device__ __forceinline__ bf16x8_t mx_tr(LAS unsigned char* p) { const s16x4_t r = __builtin_amdgcn_ds_read_tr16_b64_v4i16((LAS s16x4_t*)p); return (bf16x8_t){r[0], r[1], r[2], r[3], 0, 0, 0, 0}; }
__device__ __forceinline__ float dpp_sum16(float x) {
    x += __builtin_bit_cast(float, __builtin_amdgcn_update_dpp(0, __builtin_bit_cast(int, x), 0xB1, 0xF, 0xF, true));
    x += __builtin_bit_cast(float, __builtin_amdgcn_update_dpp(0, __builtin_bit_cast(int, x), 0x4E, 0xF, 0xF, true));
    x += __builtin_bit_cast(float, __builtin_amdgcn_update_dpp(0, __builtin_bit_cast(int, x), 0x141, 0xF, 0xF, true));
    x += __builtin_bit_cast(float, __builtin_amdgcn_update_dpp(0, __builtin_bit_cast(int, x), 0x140, 0xF, 0xF, true));
    return x;
}
__device__ __forceinline__ void mixer_mfma(Frame& F, int l) {
    unsigned char* ws = F.ws;
    const int tid = F.tid, lane = F.lane, wave = F.wave, l15 = lane & 15, g = lane >> 4, v0 = 16 * wave;
    LAS unsigned char* L = F.lds;
    const bf16* QT = (const bf16*)(ws + WS_R + R_QT); const bf16* KT = (const bf16*)(ws + WS_R + R_KT); const bf16* VR = (const bf16*)(ws + WS_R + R_VR); const bf16* GT = (const bf16*)(ws + WS_R + R_GT);
    bf16* O = (bf16*)(ws + WS_R + R_O);
    const float* DEC = (const float*)(ws + WS_R + R_DEC); const float* DECS = (const float*)(ws + WS_R + R_DECS);
    const int w = blockIdx.x;
    const int qrow_off = l15 * MX_ROWB + 8 * g;
    const int tr_off = (4 * g + (l15 >> 2)) * MX_ROWB + 8 * (l15 & 3);
    for (int it = 0;; ++it) {
        bool smp; int seq, H, nchunks, ntok, row_base;
        if (w < 64) { if (it > 0) break; smp = false; seq = w >> 3; H = w & 7; nchunks = TP / 16; ntok = 16; row_base = seq * TP; }
        else { const int id = (w - 64) + (int)(gridDim.x - 64) * it; if (id >= NS * 8) break; smp = true; seq = id >> 3; H = id & 7; nchunks = 1; ntok = 4; row_base = MP + 4 * seq; }
        const bool hg = H < 4; const int h = H & 3;
        const int nst = (nchunks + 3) >> 2;
        f32x4 Z[8];
        if (smp) { const float* S0 = (hg ? F.in[I_SHG] : F.in[I_SRT]) + (((size_t)l * NS + seq) * 4 + h) * 16384 + v0 + l15 + 4 * g * 128;
#pragma unroll
            for (int kb = 0; kb < 8; ++kb) { asm volatile("" : "+v"(S0));
#pragma unroll
                for (int r = 0; r < 4; ++r) Z[kb][r] = S0[r * 128];
                S0 += 16 * 128; } }
        else {
#pragma unroll
            for (int kb = 0; kb < 8; ++kb) Z[kb] = (f32x4){0.f, 0.f, 0.f, 0.f}; }
        const float lg = rt_log_gamma(h), Eret = __expf(lg * (float)ntok);
        const float ng = (hg ? F.in[I_HGN] : F.in[I_GNG])[l * HGW + 128 * h + v0 + l15], nb = hg ? 0.f : F.in[I_GNB][l * HGW + 128 * h + v0 + l15];
        v4u RQ[2], RK[2], RV[2], RG[2]; float RE = 0.f;
#define MX_LOADS(s_) do { const int rb_ = row_base + 64 * (s_); \
            _Pragma("unroll") for (int j_ = 0; j_ < 2; ++j_) { const int id_ = tid + 512 * j_, rr_ = id_ >> 4, cc_ = id_ & 15; \
                if ((rr_ & 15) < ntok && (rr_ >> 4) < nchunks - 4 * (s_)) { const size_t o_ = (size_t)(rb_ + rr_) * D + 128 * H + 8 * cc_; \
                    RQ[j_] = *(const v4u*)(QT + o_); RK[j_] = *(const v4u*)(KT + o_); RV[j_] = *(const v4u*)(VR + o_); RG[j_] = *(const v4u*)(GT + o_); } \
                else { RQ[j_] = (v4u){0u, 0u, 0u, 0u}; RK[j_] = RQ[j_]; RV[j_] = RQ[j_]; RG[j_] = RQ[j_]; } } \
            if (hg) { const int c_ = tid >> 7, k_ = tid & 127; RE = smp ? DECS[(size_t)seq * HGW + 128 * h + k_] : ((4 * (s_) + c_) < nchunks ? DEC[(size_t)((row_base >> 4) + 4 * (s_) + c_) * HGW + 128 * h + k_] : 0.f); } } while (0)
#define MX_WRITE(s_) do { \
            _Pragma("unroll") for (int j_ = 0; j_ < 2; ++j_) { const int id_ = tid + 512 * j_, rr_ = id_ >> 4, cc_ = id_ & 15; const int o_ = rr_ * MX_ROWB + 16 * cc_; \
                *(LAS v4u*)(L + MX_TQ + o_) = RQ[j_]; *(LAS v4u*)(L + MX_TK + o_) = RK[j_]; *(LAS v4u*)(L + MX_TV + o_) = RV[j_]; *(LAS v4u*)(L + MX_TG + ((s_) & 1) * MX_TILE + o_) = RG[j_]; } \
            ((LAS float*)(L + MX_ES))[tid] = hg ? __expf(RE) : Eret; } while (0)
        MX_LOADS(0);
        __syncthreads();
        MX_WRITE(0);
        __syncthreads();
        for (int s = 0; s < nst; ++s) {
            const int nch = (nchunks - 4 * s) < 4 ? (nchunks - 4 * s) : 4;
            if (s + 1 < nst) MX_LOADS(s + 1);
            f32x4 Oc[4];
#pragma unroll
            for (int c = 0; c < 4; ++c) {
                Oc[c] = (f32x4){0.f, 0.f, 0.f, 0.f};
                asm volatile("" ::: "memory");
                if (c < nch) {
                    LAS unsigned char* tq = L + MX_TQ + c * 16 * MX_ROWB; LAS unsigned char* tk = L + MX_TK + c * 16 * MX_ROWB; LAS unsigned char* tv = L + MX_TV + c * 16 * MX_ROWB;
                    bf16x8_t QA[4]; f32x4 pt = (f32x4){0.f, 0.f, 0.f, 0.f};
#pragma unroll
                    for (int ks = 0; ks < 4; ++ks) { QA[ks] = mx_ld2(tq + qrow_off + 64 * ks); const bf16x8_t ka = mx_ld2(tk + qrow_off + 64 * ks);
                        pt = __builtin_amdgcn_mfma_f32_16x16x32_bf16(ka, QA[ks], pt, 0, 0, 0); }
#pragma unroll
                    for (int r = 0; r < 4; ++r) pt[r] = (4 * g + r <= l15) ? pt[r] : 0.f;
                    const bf16x8_t PA = __builtin_bit_cast(bf16x8_t, (v4u){pk2(pt[0], pt[1]), pk2(pt[2], pt[3]), 0u, 0u});
                    const bf16x8_t VB = mx_tr(tv + tr_off + 2 * v0);
                    f32x4 o = __builtin_amdgcn_mfma_f32_16x16x32_bf16(PA, VB, (f32x4){0.f, 0.f, 0.f, 0.f}, 0, 0, 0);
#pragma unroll
                    for (int ks = 0; ks < 4; ++ks) { const bf16x8_t ZB = __builtin_bit_cast(bf16x8_t, (v4u){pk2(Z[2 * ks][0], Z[2 * ks][1]), pk2(Z[2 * ks][2], Z[2 * ks][3]), pk2(Z[2 * ks + 1][0], Z[2 * ks + 1][1]), pk2(Z[2 * ks + 1][2], Z[2 * ks + 1][3])});
                        o = __builtin_amdgcn_mfma_f32_16x16x32_bf16(QA[ks], ZB, o, 0, 0, 0); }
#pragma unroll
                    for (int kb = 0; kb < 8; ++kb) { const bf16x8_t KA = mx_tr(tk + tr_off + 32 * kb);
                        Z[kb] = __builtin_amdgcn_mfma_f32_16x16x32_bf16(KA, VB, Z[kb], 0, 0, 0); }
                    if (hg) {
#pragma unroll
                        for (int kb = 0; kb < 8; ++kb) Z[kb] *= *(const LAS f32x4*)(L + MX_ES + (c * 128 + 16 * kb + 4 * g) * 4); }
                    else {
#pragma unroll
                        for (int kb = 0; kb < 8; ++kb) Z[kb] *= Eret; }
                    Oc[c] = o;
#pragma unroll
                    for (int r = 0; r < 4; ++r) { const float s1 = dpp_sum16(o[r]), s2 = dpp_sum16(o[r] * o[r]);
                        if (l15 == 0) *(LAS f32x2*)(L + MX_PART + (((c * 16 + 4 * g + r) * 8 + wave) * 8)) = (f32x2){s1, s2}; }
                }
            }
            __syncthreads();
            if (s + 1 < nst) MX_WRITE(s + 1);
            if (lane < 8) { const int tok = 8 * wave + lane; float s1 = 0.f, s2 = 0.f;
#pragma unroll
                for (int q = 0; q < 4; ++q) { const f32x4 pp = *(const LAS f32x4*)(L + MX_PART + (tok * 8 + 2 * q) * 8); s1 += pp[0] + pp[2]; s2 += pp[1] + pp[3]; }
                const float mean = hg ? 0.f : s1 * (1.f / 128.f); const float rs = rsqrtf(s2 * (1.f / 128.f) - mean * mean + LN_EPS);
                *(LAS f32x2*)(L + MX_STAT + tok * 8) = (f32x2){mean, rs}; }
            __syncthreads();
#pragma unroll
            for (int c = 0; c < 4; ++c) if (c < nch) {
                LAS unsigned char* tg = L + MX_TG + (s & 1) * MX_TILE + (c * 16 + 4 * g) * MX_ROWB + 2 * (v0 + l15);
#pragma unroll
                for (int r = 0; r < 4; ++r) if (4 * g + r < ntok) {
                    const f32x2 st = *(const LAS f32x2*)(L + MX_STAT + (c * 16 + 4 * g + r) * 8);
                    const float gate = bf2f(*(const LAS unsigned short*)(tg + r * MX_ROWB));
                    const float y = ((Oc[c][r] - st.x) * st.y * ng + nb) * gate;
                    O[(size_t)(row_base + 64 * s + 16 * c + 4 * g + r) * D + 128 * H + v0 + l15] = (bf16)f2bf(y); }
            }
        }
        float* dst = F.out + (smp ? (hg ? O_HS : O_RS) + (((size_t)l * NS + seq) * 4 + h) * 16384 : (hg ? O_HP : O_RP) + (((size_t)l * NB + seq) * 4 + h) * 16384) + v0 + l15 + 4 * g * 128;
#pragma unroll
        for (int kb = 0; kb < 8; ++kb) { asm volatile("" : "+v"(dst));
#pragma unroll
            for (int r = 0; r < 4; ++r) dst[r * 128] = Z[kb][r];
            dst += 16 * 128; }
#undef MX_LOADS
#undef MX_WRITE
    }
}

__device__ __forceinline__ void unpack8(const v4u w, float (&f)[8]) {
#pragma unroll
    for (int e = 0; e < 4; ++e) { f[2 * e] = bflo(w[e]); f[2 * e + 1] = bfhi(w[e]); }
}
__device__ __forceinline__ float gelu_tanh(float x) { const float u = 0.7978845608028654f * (x + 0.044715f * x * x * x); return x / (1.0f + __expf(-2.0f * u)); }
__device__ __forceinline__ void conv_phase(Frame& F, int l) {
    unsigned char* ws = F.ws;
    const bf16* A = (const bf16*)(ws + WS_R + R_A); bf16* G = (bf16*)(ws + WS_R + R_G);
    const float* cw = F.in[I_CW] + (size_t)l * 3 * DFF; const float* cb = F.in[I_CB] + (size_t)l * DFF;
    const float* scv = F.in[I_SCV] + (size_t)l * NS * 2 * DFF;
    float* ocp = F.out + O_CP + (size_t)l * NB * 2 * DFF; float* ocs = F.out + O_CS + (size_t)l * NS * 2 * DFF;
    constexpr int FG = DFF / 8  , NRC = MPAD / 16  ;
    const int gtid = blockIdx.x * (NWAVES * 64) + F.tid, NT = gridDim.x * NWAVES * 64;
    for (int item = gtid; item < NRC * FG; item += NT) {
        const int rc = item / FG, fg = item - rc * FG, f0 = fg * 8, row0 = rc * 16;
        if (row0 >= MREAL) { for (int r = 0; r < 16; ++r) *(v4u*)(G + (size_t)(row0 + r) * DFF + f0) = (v4u){0u, 0u, 0u, 0u}; continue; }
        float w0[8], w1[8], w2[8], bb[8];
#pragma unroll
        for (int e = 0; e < 8; ++e) { w0[e] = cw[f0 + e]; w1[e] = cw[DFF + f0 + e]; w2[e] = cw[2 * DFF + f0 + e]; bb[e] = cb[f0 + e]; }
        const bool smp = row0 >= MP;
        float a1[8], a2[8];
        const int tseq = smp ? 0 : row0 - TP * (row0 / TP);
        if (!smp && tseq > 0) { unpack8(*(const v4u*)(A + (size_t)(row0 - 1) * DFF + f0), a1); unpack8(*(const v4u*)(A + (size_t)(row0 - 2) * DFF + f0), a2); }
        else {
#pragma unroll
            for (int e = 0; e < 8; ++e) { a1[e] = 0.f; a2[e] = 0.f; } }
        for (int r = 0; r < 16; ++r) {
            const int row = row0 + r;
            if (smp && (r & 3) == 0) { const int s = (row - MP) >> 2;
#pragma unroll
                for (int e = 0; e < 8; ++e) { a2[e] = scv[((size_t)s * 2 + 0) * DFF + f0 + e]; a1[e] = scv[((size_t)s * 2 + 1) * DFF + f0 + e]; } }
            float a0[8], g[8], hh[8];
            unpack8(*(const v4u*)(A + (size_t)row * DFF + f0), a0); unpack8(*(const v4u*)(G + (size_t)row * DFF + f0), g);
#pragma unroll
            for (int e = 0; e < 8; ++e) { const float cv = bb[e] + w0[e] * a2[e] + w1[e] * a1[e] + w2[e] * a0[e]; hh[e] = gelu_tanh(cv) * g[e]; }
            *(v4u*)(G + (size_t)row * DFF + f0) = (v4u){pk2(hh[0], hh[1]), pk2(hh[2], hh[3]), pk2(hh[4], hh[5]), pk2(hh[6], hh[7])};
            if (!smp) { const int t = tseq + r; if (t >= TP - 2) { float* d = ocp + ((size_t)(row0 / TP) * 2 + (t - (TP - 2))) * DFF + f0;
#pragma unroll
                    for (int e = 0; e < 8; ++e) d[e] = a0[e]; } }
            else if ((r & 3) >= 2) { float* d = ocs + ((size_t)((row - MP) >> 2) * 2 + ((r & 3) - 2)) * DFF + f0;
#pragma unroll
                for (int e = 0; e < 8; ++e) d[e] = a0[e]; }
#pragma unroll
            for (int e = 0; e < 8; ++e) { a2[e] = a1[e]; a1[e] = a0[e]; }
        }
    }
}

__device__ __forceinline__ void final_phase(Frame& F) {
    unsigned char* ws = F.ws;
    const float* Y = (const float*)(ws + WS_Y); const f32x2* st = stats_ptr(ws, 4);
    const float* g = F.in[I_L2G] + 3 * D; const float* b = F.in[I_L2B] + 3 * D;
    const int gw = blockIdx.x * NWAVES + F.wave, NGW = gridDim.x * NWAVES, lane = F.lane;
    for (int row = gw; row < MREAL; row += NGW) {
        float* dst;
        if (row < MP) { const int bb = row / TP, t = row - bb * TP; if (t < NMETA) continue; dst = F.out + O_YP + ((size_t)bb * SEQP + (t - NMETA)) * D; }
        else dst = F.out + O_YS + (size_t)(row - MP) * D;
        const f32x2 s = st[row]; const float mu = s.x * (1.f / D), rstd = rsqrtf(s.y * (1.f / D) - mu * mu + LN_EPS);
#pragma unroll
        for (int j = 0; j < 4; ++j) { const f32x4 y = ((const f32x4*)(Y + (size_t)row * D))[lane + 64 * j]; const f32x4 gg = ((const f32x4*)g)[lane + 64 * j], bb = ((const f32x4*)b)[lane + 64 * j];
            ((f32x4*)dst)[lane + 64 * j] = (y - mu) * rstd * gg + bb; }
    }
}

#ifndef ONE_LAUNCH
#define ONE_LAUNCH 1
#endif
constexpr int NPHASES = 2 + 6 * DEPTH;
struct Args { const float* in[23]; float* out; unsigned char* ws; int ph_lo, ph_hi; };
template <int ONLY_SUB> __global__ void __launch_bounds__(NWAVES * 64, 2) hymba_fwd(Args args) {
    extern __shared__ __attribute__((aligned(16))) unsigned char lds[];
    Frame F;
    F.lds = (LAS unsigned char*)lds;
    F.tid = threadIdx.x; F.lane = F.tid & 63; F.wave = __builtin_amdgcn_readfirstlane(F.tid >> 6);
    F.in = args.in; F.out = args.out; F.ws = args.ws;
    for (int u = F.tid; u < (LDS_BYTES - LDSCTL_OFF) / 4; u += NWAVES * 64) ((LAS unsigned*)(F.lds + LDSCTL_OFF))[u] = 0u;
    __syncthreads();
#if ONE_LAUNCH
    XcdBarrier bar = xcd_barrier_post((unsigned*)(args.ws + WS_CTL) + CW_BAR, (volatile LAS unsigned*)(F.lds + MISC_OFF) + 8);
#define SEAM() xcd_barrier(bar)
#else
#define SEAM() do {} while (0)
#endif
    const int lo = args.ph_lo, hi = args.ph_hi;
    const int G = gridDim.x, cid = blockIdx.x;
#ifndef SUBMASK
#define SUBMASK 0xFFFF
#endif
#define SUBON(x) ((ONLY_SUB < 0 && ((SUBMASK >> (x)) & 1)) || ONLY_SUB == (x))
    if (lo == 0 && SUBON(10)) { p0_prologue(F); if (hi > 1) SEAM(); }
    for (int ph = (lo > 1 ? lo : 1); ph < (hi < NPHASES - 1 ? hi : NPHASES - 1); ++ph) {
        { int t_ = threadIdx.x; asm volatile("" : "+v"(t_)); F.tid = t_; F.lane = t_ & 63; F.wave = __builtin_amdgcn_readfirstlane(t_ >> 6);
          unsigned long long w_ = (unsigned long long)args.ws, o_ = (unsigned long long)args.out; asm volatile("" : "+s"(w_), "+s"(o_));
          F.ws = (unsigned char*)w_; F.out = (float*)o_; }
        unsigned char* ws = F.ws;
        {
            const int l = (ph - 1) / 6, sub = (ph - 1) % 6;
            if (sub == 0 && SUBON(0)) {
                pg8::Gemm g{(const bf16*)(ws + WS_YB), w_ptr(ws, l, W_IN), MPAD, NPROJ, D}; pg8::StaticOrder S; S.init(MPAD, NPROJ, G, cid);
                EpiIn E{stats_ptr(ws, l), gw_ptr(ws, l, 0), gw_ptr(ws, l, 1), (const float*)(ws + WS_SMALL + SM_LB) + l * HGW, (const f32x2*)(ws + WS_SMALL + SM_ROPE),
                        (bf16*)(ws + WS_R + R_QT), (bf16*)(ws + WS_R + R_KT), (bf16*)(ws + WS_R + R_VR), (bf16*)(ws + WS_R + R_GT), (float*)(ws + WS_R + R_DEC), (float*)(ws + WS_R + R_DECS)};
#ifdef DUP_GEMM
                for (int rep_ = 0; rep_ < args.ph_hi - 24; ++rep_) { pg8::gemm_phase<EpiIn, pg8::StaticOrder, true, true>(F.lds, g, S, E); SEAM(); }
#else
                pg8::gemm_phase<EpiIn, pg8::StaticOrder, true, true>(F.lds, g, S, E);
#endif
            } else if (sub == 1 && SUBON(1)) {
#ifdef NAIVE_MIX
                mixer_naive(F, l);
#else
                mixer_mfma(F, l);
#endif
            } else if (sub == 2 && SUBON(2)) {
                pg8::Gemm g{(const bf16*)(ws + WS_R + R_O), w_ptr(ws, l, W_O), MPAD, D, D}; pg8::StaticOrder S; S.init(MPAD, D, G, cid);
                const float* lg = l ? F.in[I_L2G] + (l - 1) * D : (const float*)(ws + WS_SMALL + SM_ONES);
                const float* lb = l ? F.in[I_L2B] + (l - 1) * D : (const float*)(ws + WS_CTL + 1024);
                EpiRes E{(const float*)(ws + WS_Y), (float*)(ws + WS_Y1), (bf16*)(ws + WS_YB), stats_ptr(ws, l), lg, lb, stats_ptr(ws, 5 + l)};
                pg8::gemm_phase<EpiRes, pg8::StaticOrder, true, true>(F.lds, g, S, E);
            } else if (sub == 3 && SUBON(3)) {
                pg8::Gemm g{(const bf16*)(ws + WS_YB), w_ptr(ws, l, W_AB), MPAD, NAB, D}; pg8::StaticOrder S; S.init(MPAD, NAB, G, cid);
                EpiUp E{stats_ptr(ws, 5 + l), gw_ptr(ws, l, 2), gw_ptr(ws, l, 3), (bf16*)(ws + WS_R + R_A), (bf16*)(ws + WS_R + R_G)};
                pg8::gemm_phase<EpiUp, pg8::StaticOrder, true, true>(F.lds, g, S, E);
            } else if (sub == 4 && SUBON(4)) {
                conv_phase(F, l);
            } else if (SUBON(5)) {
                pg8::Gemm g{(const bf16*)(ws + WS_R + R_G), w_ptr(ws, l, W_DN), MPAD, D, DFF}; pg8::StaticOrder S; S.init(MPAD, D, G, cid);
                EpiRes E{(const float*)(ws + WS_Y1), (float*)(ws + WS_Y), (bf16*)(ws + WS_YB), stats_ptr(ws, 5 + l), F.in[I_L1G] + l * D, F.in[I_L1B] + l * D, stats_ptr(ws, l + 1)};
                pg8::gemm_phase<EpiRes, pg8::StaticOrder, true, true>(F.lds, g, S, E);
            }
        }
        if (ph + 1 < hi) SEAM();
    }
    if (hi == NPHASES && SUBON(11)) {
        { int t_ = threadIdx.x; asm volatile("" : "+v"(t_)); F.tid = t_; F.lane = t_ & 63; F.wave = __builtin_amdgcn_readfirstlane(t_ >> 6); F.ws = args.ws; F.out = args.out; }
        final_phase(F); }
}

extern "C" void kernel_launch(void* const* d_in, const int* in_sizes, int n_in, void* d_out, int out_size, void* d_ws, size_t ws_size, hipStream_t stream) {
    static int grid = 0;
    if (grid == 0) {
        if (n_in != 23 || out_size != (int)O_END || ws_size < WS_END) { fprintf(stderr, "kernel_launch: unexpected shapes: n_in %d out %d ws %zu (need %zu)\n", n_in, out_size, ws_size, (size_t)WS_END); grid = -1; return; }
        int dev = 0, cus = 0;
        if (hipGetDevice(&dev) != hipSuccess || hipDeviceGetAttribute(&cus, hipDeviceAttributeMultiprocessorCount, dev) != hipSuccess) { grid = -1; return; }
        bool ok = true;
#if ONE_LAUNCH
        ok = ok && hipFuncSetAttribute((const void*)hymba_fwd<-1>, hipFuncAttributeMaxDynamicSharedMemorySize, LDS_BYTES) == hipSuccess;
#else
        ok = ok && hipFuncSetAttribute((const void*)hymba_fwd<0>, hipFuncAttributeMaxDynamicSharedMemorySize, LDS_BYTES) == hipSuccess;
        ok = ok && hipFuncSetAttribute((const void*)hymba_fwd<1>, hipFuncAttributeMaxDynamicSharedMemorySize, LDS_BYTES) == hipSuccess;
        ok = ok && hipFuncSetAttribute((const void*)hymba_fwd<2>, hipFuncAttributeMaxDynamicSharedMemorySize, LDS_BYTES) == hipSuccess;
        ok = ok && hipFuncSetAttribute((const void*)hymba_fwd<3>, hipFuncAttributeMaxDynamicSharedMemorySize, LDS_BYTES) == hipSuccess;
        ok = ok && hipFuncSetAttribute((const void*)hymba_fwd<4>, hipFuncAttributeMaxDynamicSharedMemorySize, LDS_BYTES) == hipSuccess;
        ok = ok && hipFuncSetAttribute((const void*)hymba_fwd<5>, hipFuncAttributeMaxDynamicSharedMemorySize, LDS_BYTES) == hipSuccess;
        ok = ok && hipFuncSetAttribute((const void*)hymba_fwd<10>, hipFuncAttributeMaxDynamicSharedMemorySize, LDS_BYTES) == hipSuccess;
        ok = ok && hipFuncSetAttribute((const void*)hymba_fwd<11>, hipFuncAttributeMaxDynamicSharedMemorySize, LDS_BYTES) == hipSuccess;
#endif
        if (!ok) { fprintf(stderr, "kernel_launch: hipFuncSetAttribute failed\n"); grid = -1; return; }
        (void)hipGetLastError();
        grid = cus;
    }
    if (grid < 0) return;
    (void)hipMemsetAsync((char*)d_ws + WS_CTL, 0, CTL_ZERO_BYTES, stream);
    Args a{};
    for (int i = 0; i < 23; ++i) a.in[i] = (const float*)d_in[i];
    a.out = (float*)d_out; a.ws = (unsigned char*)d_ws;
#if ONE_LAUNCH
    a.ph_lo = 0; a.ph_hi = NPHASES;
    hipLaunchKernelGGL(hymba_fwd<-1>, dim3(grid), dim3(NWAVES * 64), LDS_BYTES, stream, a);
#else
    for (int p = 0; p < NPHASES; ++p) { a.ph_lo = p; a.ph_hi = p + 1;
        const int sub = p == 0 ? 10 : p == NPHASES - 1 ? 11 : (p - 1) % 6;
        switch (sub) {
            case 0: hipLaunchKernelGGL(hymba_fwd<0>, dim3(grid), dim3(NWAVES * 64), LDS_BYTES, stream, a); break;
            case 1: hipLaunchKernelGGL(hymba_fwd<1>, dim3(grid), dim3(NWAVES * 64), LDS_BYTES, stream, a); break;
            case 2: hipLaunchKernelGGL(hymba_fwd<2>, dim3(grid), dim3(NWAVES * 64), LDS_BYTES, stream, a); break;
            case 3: hipLaunchKernelGGL(hymba_fwd<3>, dim3(grid), dim3(NWAVES * 64), LDS_BYTES, stream, a); break;
            case 4: hipLaunchKernelGGL(hymba_fwd<4>, dim3(grid), dim3(NWAVES * 64), LDS_BYTES, stream, a); break;
            case 5: hipLaunchKernelGGL(hymba_fwd<5>, dim3(grid), dim3(NWAVES * 64), LDS_BYTES, stream, a); break;
            case 10: hipLaunchKernelGGL(hymba_fwd<10>, dim3(grid), dim3(NWAVES * 64), LDS_BYTES, stream, a); break;
            default: hipLaunchKernelGGL(hymba_fwd<11>, dim3(grid), dim3(NWAVES * 64), LDS_BYTES, stream, a); break;
        }
    }
#endif
}
```

```cpp
#include <hip/hip_runtime.h>
#include <cstdio>
#include <cstdint>
namespace pg8 {
#define PG8_LAS __attribute__((address_space(3)))
typedef unsigned short bf16_t;
typedef short bf16x8 __attribute__((ext_vector_type(8)));
typedef float f32x4 __attribute__((ext_vector_type(4)));
typedef unsigned u32x4 __attribute__((ext_vector_type(4)));
constexpr int BM = 256, BK = 64, HALF = 128, HTB = HALF * BK * 2  , STAGE_BYTES = 8 * HTB, NXCD = 8, WGM = 8;

__host__ __device__ __forceinline__ int lds_byte(int r, int c) { const int st = (r >> 4) * 2 + (c >> 5), rr = r & 15, cc = c & 31, ob = rr * 64 + cc * 2; return st * 1024 + (ob ^ (((ob >> 9) & 1) << 5)); }
__host__ __device__ __forceinline__ void stage_rc(int b, int& R, int& C) { const int st = b / 1024, sb = b % 1024, swz = sb ^ (((sb >> 9) & 1) << 5); R = (st >> 1) * 16 + swz / 64; C = (st & 1) * 32 + (swz % 64) / 2; }
__host__ __device__ __forceinline__ int perm32(int rho) { const int n = rho >> 4, i = rho & 15; return 8 * (i >> 2) + 4 * n + (i & 3); }

struct Unit { int pm, pn; };
struct Gemm { const bf16_t* A; const bf16_t* Bt; int M, N, K; };

struct StaticOrder {
    int nM, nN, nwg, G, c;
    __host__ __device__ void init(int M, int N, int G_, int c_) { nM = M / BM; nN = N / BM; nwg = nM * nN; G = G_; c = c_; }
    __host__ __device__ bool next(int i, Unit& u) const {
        const long L = (long)i * G + c; if (L >= nwg) return false;
        int wgid = (int)L; { const int q = nwg / NXCD, r = nwg % NXCD, xcd = wgid % NXCD, off = wgid / NXCD; wgid = (xcd < r ? xcd * (q + 1) : r * (q + 1) + (xcd - r) * q) + off; }
        const int nig = WGM * nN, gid = wgid / nig, fm = gid * WGM, gsz = (nM - fm) < WGM ? (nM - fm) : WGM;
        u.pm = fm + ((wgid % nig) % gsz); u.pn = (wgid % nig) / gsz; return true;
    }
    __device__ __forceinline__ void a_ready(const Unit&) const {}
    __device__ __forceinline__ void done(const Unit&) const {}
};

__device__ __forceinline__ unsigned cvt_pk_bf16(float lo, float hi) { unsigned r; asm volatile("v_cvt_pk_bf16_f32 %0, %1, %2" : "=v"(r) : "v"(lo), "v"(hi)); return r; }
template <class Epi, class Sched, bool ALIGN_EPI = false, bool SP2 = false>
__device__ __forceinline__ void gemm_phase(PG8_LAS unsigned char* lds, const Gemm g, const Sched& S, const Epi& E) {
    int tid_ = threadIdx.x; asm volatile("" : "+v"(tid_));
    const int tid = tid_, wid = __builtin_amdgcn_readfirstlane(tid >> 6), lane = tid & 63, wr = wid >> 2, wc = wid & 3, fr = lane & 15, fq = lane >> 4;
    const int K = g.K, nt = K / BK;
    unsigned voffA[2], voffB[2];
#pragma unroll
    for (int i = 0; i < 2; ++i) { int R, C; stage_rc(tid * 16 + i * 8192, R, C); const int Rb = Epi::PERM ? ((R & ~31) + perm32(R & 31)) : R;
        voffA[i] = (unsigned)(R * K + C) * 2u; voffB[i] = (unsigned)(Rb * K + C) * 2u; }
    const size_t kstep = (size_t)(BK * 2);
    const size_t hstep = (size_t)HALF * K * 2;
    const size_t tstep = 2 * hstep;
    const unsigned ldsw = (unsigned)wid * 1024u;
    const int aoff = lds_byte(wr * 64 + fr, fq * 8), boff = lds_byte(wc * 32 + fr, fq * 8);
#define PG8_SA(b, h) (((b) * 2 + (h)) * HTB)
#define PG8_SB(b, h) ((4 + (b) * 2 + (h)) * HTB)
#define PG8_STAGE(bufoff, gbase, voff) do { _Pragma("unroll") for (int _i = 0; _i < 2; ++_i) \
        __builtin_amdgcn_global_load_lds((const unsigned*)((const char*)(gbase) + (voff)[_i]), (PG8_LAS unsigned*)(lds + (bufoff) + ldsw + _i * 8192), 16, 0, 0); } while (0)
#define PG8_LDA(dst, b, h) do { _Pragma("unroll") for (int m = 0; m < 4; ++m) _Pragma("unroll") for (int k = 0; k < 2; ++k) dst[m][k] = *(const PG8_LAS bf16x8*)(lds + PG8_SA(b, h) + aoff + m * 2048 + k * 1024); } while (0)
#define PG8_LDB(dst, b, h) do { _Pragma("unroll") for (int n = 0; n < 2; ++n) _Pragma("unroll") for (int k = 0; k < 2; ++k) dst[n][k] = *(const PG8_LAS bf16x8*)(lds + PG8_SB(b, h) + boff + n * 2048 + k * 1024); } while (0)
#define PG8_MMA(ai, bj, At, Bt) do { __builtin_amdgcn_s_setprio(1); _Pragma("unroll") for (int m = 0; m < 4; ++m) _Pragma("unroll") for (int n = 0; n < 2; ++n) _Pragma("unroll") for (int k = 0; k < 2; ++k) \
        acc[ai][bj][m][n] = __builtin_amdgcn_mfma_f32_16x16x32_bf16(Bt[n][k], At[m][k], acc[ai][bj][m][n], 0, 0, 0); __builtin_amdgcn_s_setprio(0); } while (0)
#define PG8_WAIT_V(n) asm volatile("s_waitcnt vmcnt(" #n ")" ::: "memory")
#define PG8_WAIT_L(n) asm volatile("s_waitcnt lgkmcnt(" #n ")" ::: "memory")
#define PG8_BAR __builtin_amdgcn_s_barrier()
#define PG8_SCHED __builtin_amdgcn_sched_barrier(0)
    Unit cur, nxt; int ui = 0;
    if (!S.next(0, cur)) return;
    f32x4 acc[2][2][4][2];
#pragma unroll
    for (int a = 0; a < 2; ++a)
#pragma unroll
        for (int b = 0; b < 2; ++b)
#pragma unroll
            for (int m = 0; m < 4; ++m)
#pragma unroll
                for (int n = 0; n < 2; ++n) acc[a][b][m][n] = (f32x4){0.f, 0.f, 0.f, 0.f};
    bf16x8 At[4][2], B0[2][2], B1[2][2];
    const char* cA = (const char*)g.A + (size_t)cur.pm * tstep; const char* cB = (const char*)g.Bt + (size_t)cur.pn * tstep;
    S.a_ready(cur);
    if constexpr (SP2) {
        PG8_STAGE(PG8_SB(0, 0), cB, voffB); PG8_STAGE(PG8_SB(0, 1), cB + hstep, voffB); PG8_STAGE(PG8_SA(0, 0), cA, voffA); PG8_STAGE(PG8_SA(0, 1), cA + hstep, voffA);
        if (wr == 1) PG8_BAR;
        PG8_WAIT_V(2); PG8_BAR;
        PG8_STAGE(PG8_SB(1, 0), cB + kstep, voffB); PG8_STAGE(PG8_SA(1, 0), cA + kstep, voffA); PG8_STAGE(PG8_SB(1, 1), cB + hstep + kstep, voffB);
        PG8_WAIT_V(6); PG8_BAR;
    } else {
        PG8_STAGE(PG8_SB(0, 0), cB, voffB); PG8_STAGE(PG8_SA(0, 0), cA, voffA); PG8_STAGE(PG8_SB(0, 1), cB + hstep, voffB); PG8_STAGE(PG8_SA(0, 1), cA + hstep, voffA);
        if (wr == 1) PG8_BAR;
        PG8_WAIT_V(4); PG8_BAR;
        PG8_STAGE(PG8_SB(1, 0), cB + kstep, voffB); PG8_STAGE(PG8_SA(1, 0), cA + kstep, voffA); PG8_STAGE(PG8_SB(1, 1), cB + hstep + kstep, voffB);
        PG8_WAIT_V(6); PG8_BAR;
    }
    for (;;) {
        const bool has_next = S.next(ui + 1, nxt);
        const char* nA = has_next ? (const char*)g.A + (size_t)nxt.pm * tstep : cA; const char* nB = has_next ? (const char*)g.Bt + (size_t)nxt.pn * tstep : cB;
        for (int t = 0; t < nt; t += 2) {
            const bool last = (t == nt - 2);
            const char* a1 = cA + (size_t)(t + 1) * kstep;
            const char* a2 = last ? nA : cA + (size_t)(t + 2) * kstep; const char* b2 = last ? nB : cB + (size_t)(t + 2) * kstep;
            const char* a3 = a2 + kstep; const char* b3 = b2 + kstep;
            if (last && has_next) S.a_ready(nxt);
            if constexpr (SP2) {
            PG8_LDB(B0, 0, 0); PG8_LDB(B1, 0, 1); PG8_SCHED; PG8_LDA(At, 0, 0); PG8_STAGE(PG8_SA(1, 1), a1 + hstep, voffA);
            PG8_WAIT_V(8); PG8_WAIT_L(0); PG8_BAR; PG8_MMA(0, 0, At, B0); PG8_MMA(0, 1, At, B1); PG8_BAR; PG8_SCHED;
            PG8_LDA(At, 0, 1); PG8_STAGE(PG8_SB(0, 0), b2, voffB); PG8_STAGE(PG8_SB(0, 1), b2 + hstep, voffB); PG8_STAGE(PG8_SA(0, 0), a2, voffA);
            PG8_WAIT_V(8); PG8_WAIT_L(0); PG8_BAR; PG8_MMA(1, 0, At, B0); PG8_MMA(1, 1, At, B1); PG8_BAR; PG8_SCHED;
            PG8_LDB(B0, 1, 0); PG8_LDB(B1, 1, 1); PG8_SCHED; PG8_LDA(At, 1, 0); PG8_STAGE(PG8_SA(0, 1), a2 + hstep, voffA);
            PG8_WAIT_V(8); PG8_WAIT_L(0); PG8_BAR; PG8_MMA(0, 0, At, B0); PG8_MMA(0, 1, At, B1); PG8_BAR; PG8_SCHED;
            PG8_LDA(At, 1, 1); PG8_STAGE(PG8_SB(1, 0), b3, voffB); PG8_STAGE(PG8_SB(1, 1), b3 + hstep, voffB); PG8_STAGE(PG8_SA(1, 0), a3, voffA);
            PG8_WAIT_V(8); PG8_WAIT_L(0); PG8_BAR; PG8_MMA(1, 0, At, B0); PG8_MMA(1, 1, At, B1); PG8_BAR; PG8_SCHED;
            } else {
            PG8_LDB(B0, 0, 0); PG8_SCHED; PG8_LDA(At, 0, 0); PG8_STAGE(PG8_SA(1, 1), a1 + hstep, voffA);
            PG8_WAIT_L(8); PG8_BAR; PG8_WAIT_L(0); PG8_MMA(0, 0, At, B0); PG8_BAR; PG8_SCHED;
            PG8_LDB(B1, 0, 1); PG8_STAGE(PG8_SB(0, 0), b2, voffB);
            PG8_BAR; PG8_WAIT_L(0); PG8_MMA(0, 1, At, B1); PG8_BAR;
            PG8_LDA(At, 0, 1); PG8_STAGE(PG8_SA(0, 0), a2, voffA);
            PG8_BAR; PG8_WAIT_L(0); PG8_MMA(1, 0, At, B0); PG8_BAR; PG8_SCHED;
            PG8_STAGE(PG8_SB(0, 1), b2 + hstep, voffB);
            PG8_WAIT_V(6); PG8_BAR; PG8_MMA(1, 1, At, B1); PG8_BAR;
            PG8_LDB(B0, 1, 0); PG8_SCHED; PG8_LDA(At, 1, 0); PG8_STAGE(PG8_SA(0, 1), a2 + hstep, voffA);
            PG8_WAIT_L(8); PG8_BAR; PG8_WAIT_L(0); PG8_MMA(0, 0, At, B0); PG8_BAR; PG8_SCHED;
            PG8_LDB(B1, 1, 1); PG8_STAGE(PG8_SB(1, 0), b3, voffB);
            PG8_BAR; PG8_WAIT_L(0); PG8_MMA(0, 1, At, B1); PG8_BAR;
            PG8_LDA(At, 1, 1); PG8_STAGE(PG8_SA(1, 0), a3, voffA);
            PG8_BAR; PG8_WAIT_L(0); PG8_MMA(1, 0, At, B0); PG8_BAR; PG8_SCHED;
            PG8_STAGE(PG8_SB(1, 1), b3 + hstep, voffB);
            PG8_WAIT_V(6); PG8_BAR; PG8_MMA(1, 1, At, B1); PG8_BAR;
            }
        }
        if constexpr (ALIGN_EPI) { if (wr == 0) PG8_BAR; }
        if constexpr (!Epi::AFTER_DRAIN) { E(acc, cur, wr, wc, fr, fq); S.done(cur); }
        if (!has_next) break;
#pragma unroll
        for (int a = 0; a < 2; ++a)
#pragma unroll
            for (int b = 0; b < 2; ++b)
#pragma unroll
                for (int m = 0; m < 4; ++m)
#pragma unroll
                    for (int n = 0; n < 2; ++n) acc[a][b][m][n] = (f32x4){0.f, 0.f, 0.f, 0.f};
        cur = nxt; cA = nA; cB = nB; ++ui;
        if constexpr (ALIGN_EPI) { if (wr == 1) PG8_BAR; }
    }
    PG8_WAIT_V(0);
    if constexpr (!ALIGN_EPI) { if (wr == 0) PG8_BAR; }
    PG8_BAR;
    if constexpr (Epi::AFTER_DRAIN) { E.fused(acc, cur, wr, wc, fr, fq, lds, wid, lane); S.done(cur); }
#undef PG8_SA
#undef PG8_SB
#undef PG8_STAGE
#undef PG8_LDA
#undef PG8_LDB
#undef PG8_MMA
#undef PG8_WAIT_V
#undef PG8_WAIT_L
#undef PG8_BAR
#undef PG8_SCHED
}
}

constexpr int NWAVES = 8;
constexpr int D = 1024, NB = 8, TP = 2064, MP = NB * TP  , NS = 128, TS = 4, MS = NS * TS, MREAL = MP + MS  , MPAD = 17152  ;
constexpr int DEPTH = 4, HGW = 512, NPROJ = 4096, DFF = 2816, NAB = 2 * DFF, SEQP = 2048, NMETA = 16;
constexpr int NPOS = TP + TS;
constexpr float LN_EPS = 1e-5f, F_EPS = 1e-6f;
constexpr float ALPHA = 1.6817928305074290f;
constexpr float RT_KSCALE = 0.08838834764831845f;

constexpr size_t MiB = 1u << 20;
constexpr size_t WS_CTL = 0, CTL_ZERO_BYTES = 2 * MiB;
constexpr size_t CTL_STATS = 256 * 1024;
constexpr size_t CTL_GW = 1536 * 1024;
constexpr int GW_PER_LAYER = 2 * NPROJ + 2 * NAB;
static_assert(CTL_STATS + 9 * (size_t)MPAD * 8 <= CTL_GW && CTL_GW + (size_t)DEPTH * GW_PER_LAYER * 4 <= CTL_ZERO_BYTES, "ctl map");
constexpr size_t WS_SMALL = 2 * MiB;
constexpr size_t SM_LB = 0, SM_ONES = 8192, SM_ROPE = 16384;
static_assert(SM_ROPE + (size_t)NPOS * 64 * 8 <= 2 * MiB, "small map");
constexpr size_t WS_W = 4 * MiB;
constexpr size_t W_LAYER = (size_t)(NPROJ + D + NAB) * D * 2 + (size_t)D * DFF * 2;
constexpr size_t W_IN = 0, W_O = (size_t)NPROJ * D * 2, W_AB = W_O + (size_t)D * D * 2, W_DN = W_AB + (size_t)NAB * D * 2;
constexpr size_t WS_Y = 112 * MiB, WS_Y1 = 179 * MiB, WS_YB = 246 * MiB, WS_R = 280 * MiB;
static_assert(WS_W + DEPTH * W_LAYER <= WS_Y && (size_t)MPAD * D * 4 == 67 * MiB, "weights/y map");
constexpr size_t ACT = (size_t)MPAD * D * 2;
constexpr size_t R_QT = 0, R_KT = ACT, R_VR = 2 * ACT, R_GT = 3 * ACT, R_O = 4 * ACT, R_KTT = 5 * ACT, R_VTT = 6 * ACT, R_DEC = 7 * ACT, R_DECS = R_DEC + (size_t)(MPAD / 16) * HGW * 4;
constexpr size_t R_A = 0, R_G = (size_t)MPAD * DFF * 2;
constexpr size_t WS_END = WS_R + 240 * MiB;
static_assert(R_DECS + (size_t)NS * HGW * 4 <= 240 * MiB && R_G * 2 <= R_O + 0 * ACT + 240 * MiB, "region map");
static_assert(R_G * 2 <= 240 * MiB, "ffn overlay");

constexpr int CW_BAR = 4096;

constexpr int RING_BYTES = 131072, LDSCTL_OFF = RING_BYTES, MISC_OFF = LDSCTL_OFF + 320, LDS_BYTES = 147456;

#define GAS __attribute__((address_space(1)))
#define LAS __attribute__((address_space(3)))
typedef unsigned short bf16;
typedef unsigned v4u __attribute__((ext_vector_type(4)));
typedef unsigned v2u __attribute__((ext_vector_type(2)));
typedef float f32x4 __attribute__((ext_vector_type(4)));
typedef float f32x2 __attribute__((ext_vector_type(2)));
#define LDS_WAIT() asm volatile("s_waitcnt lgkmcnt(0)" ::: "memory")
#define VM_WAIT() asm volatile("s_waitcnt vmcnt(0)" ::: "memory")
__device__ __forceinline__ unsigned f2bf(float f) { unsigned u = __builtin_bit_cast(unsigned, f); return (u + 0x7fffu + ((u >> 16) & 1u)) >> 16; }
__device__ __forceinline__ float bf2f(unsigned h) { return __builtin_bit_cast(float, h << 16); }
__device__ __forceinline__ float bflo(unsigned w) { return __builtin_bit_cast(float, w << 16); }
__device__ __forceinline__ float bfhi(unsigned w) { return __builtin_bit_cast(float, w & 0xffff0000u); }
__device__ __forceinline__ unsigned pk2(float lo, float hi) { return pg8::cvt_pk_bf16(lo, hi); }
__device__ __forceinline__ float sigmoidf_(float x) { return 1.0f / (1.0f + __expf(-x)); }

#define XB_TMO      128
#define XB_XCNT(j)  (256  + 64 * (j))
#define XB_XSUB(j)  (1280 + 64 * (j))
#define XB_XGEN(j)  (2304 + 64 * (j))
#define XB_TOP      3328
#define XB_TOPGEN   3392
#define XCD_BAR_WORDS 3456
#define XB_SPIN_CAP (1u << 18)

__device__ __forceinline__ unsigned xb_ld(unsigned* p)              { return __hip_atomic_load(p, __ATOMIC_RELAXED, __HIP_MEMORY_SCOPE_AGENT); }
__device__ __forceinline__ unsigned xb_add(unsigned* p, unsigned v) { return __hip_atomic_fetch_add(p, v, __ATOMIC_RELAXED, __HIP_MEMORY_SCOPE_AGENT); }
__device__ __forceinline__ unsigned xb_xcc_id() { return (unsigned)__builtin_amdgcn_s_getreg((3 << 11) | 20) & 0xFu; }
#define XB_SPIN(cond, bar) do { unsigned _sp = 0; while (cond) { __builtin_amdgcn_s_sleep(1); \
    if ((++_sp & 255u) == 0u) { if (xb_ld(&(bar)[XB_TMO])) break; if (_sp > XB_SPIN_CAP) { atomicAdd(&(bar)[XB_TMO], 1u); break; } } } } while (0)

struct XcdBarrier {
    unsigned* bar; unsigned x;
    volatile LAS unsigned* st;
};

__device__ __forceinline__ XcdBarrier xcd_barrier_post(unsigned* bar, volatile LAS unsigned* st) {
    XcdBarrier b; b.bar = bar; b.x = xb_xcc_id(); b.st = st;
    if (threadIdx.x == 0) (void)xb_add(&bar[XB_XCNT(b.x)], 1u);
    return b;
}
__device__ __forceinline__ void xcd_barrier_complete(unsigned* bar, unsigned x, unsigned& nloc, unsigned& nx) {
    const unsigned G = gridDim.x * gridDim.y * gridDim.z;
    unsigned sum, cnt, mine, sp = 0u;
    for (;;) {
        sum = 0u; cnt = 0u; mine = 0u;
#pragma unroll
        for (unsigned j = 0; j < 16; ++j) { const unsigned c = xb_ld(&bar[XB_XCNT(j)]); sum += c; cnt += (c > 0u) ? 1u : 0u; mine = (j == x) ? c : mine; }
        if (sum == G) break;
        __builtin_amdgcn_s_sleep(1);
        if ((++sp & 255u) == 0u) { if (xb_ld(&bar[XB_TMO])) break; if (sp > XB_SPIN_CAP) { atomicAdd(&bar[XB_TMO], 1u); break; } }
    }
    nloc = mine > 0u ? mine : 1u; nx = cnt > 0u ? cnt : 1u;
}

__device__ __forceinline__ void xcd_barrier(const XcdBarrier& b) {
    asm volatile("s_waitcnt vmcnt(0)" ::: "memory");
    __syncthreads();
    if (threadIdx.x == 0) {
        unsigned* bar = b.bar;
        __builtin_amdgcn_s_waitcnt(0);
        unsigned nloc = b.st[0], nx = b.st[1];
        if (nloc == 0u) { xcd_barrier_complete(bar, b.x, nloc, nx); b.st[0] = nloc; b.st[1] = nx; }
        const unsigned old = xb_add(&bar[XB_XSUB(b.x)], 1u);
        const unsigned gen = old / nloc;
        if (old + 1u == (gen + 1u) * nloc) {
            __builtin_amdgcn_fence(__ATOMIC_RELEASE, "agent");
            asm volatile("s_waitcnt vmcnt(0)" ::: "memory");
            const unsigned og = xb_add(&bar[XB_TOP], 1u);
            const unsigned tg = og / nx;
            if (og + 1u == (tg + 1u) * nx) xb_add(&bar[XB_TOPGEN], 1u);
            else XB_SPIN(xb_ld(&bar[XB_TOPGEN]) == tg, bar);
            __builtin_amdgcn_fence(__ATOMIC_ACQUIRE, "agent");
            xb_add(&bar[XB_XGEN(b.x)], 1u);
            asm volatile("s_waitcnt vmcnt(0)" ::: "memory");
        } else {
            XB_SPIN(xb_ld(&bar[XB_XGEN(b.x)]) == gen, bar);
            __builtin_amdgcn_fence(__ATOMIC_ACQUIRE, "agent");
            asm volatile("s_waitcnt vmcnt(0)" ::: "memory");
        }
    }
    __syncthreads();
}


struct Frame {
    LAS unsigned char* lds;
    int tid, lane, wave;
    const float* const* in;
    float* out; unsigned char* ws;
};
enum { I_XP = 0, I_XS, I_SHG, I_SRT, I_SCV, I_META, I_EG, I_EB, I_LBL, I_WIN, I_HGN, I_GNG, I_GNB, I_WO, I_L1G, I_L1B, I_WA, I_WB, I_CW, I_CB, I_WD, I_L2G, I_L2B };
constexpr size_t O_YP = 0, O_YS = O_YP + (size_t)NB * SEQP * D, O_HP = O_YS + (size_t)NS * TS * D, O_HS = O_HP + (size_t)DEPTH * NB * 4 * 16384,
                 O_RP = O_HS + (size_t)DEPTH * NS * 4 * 16384, O_RS = O_RP + (size_t)DEPTH * NB * 4 * 16384, O_CP = O_RS + (size_t)DEPTH * NS * 4 * 16384,
                 O_CS = O_CP + (size_t)DEPTH * NB * 2 * DFF, O_END = O_CS + (size_t)DEPTH * NS * 2 * DFF;
static_assert(O_END == 91668480, "output size");

__device__ __forceinline__ f32x2* stats_ptr(unsigned char* ws, int idx) { return (f32x2*)(ws + WS_CTL + CTL_STATS) + (size_t)idx * MPAD; }
__device__ __forceinline__ float* gw_ptr(unsigned char* ws, int l, int which) {
    float* p = (float*)(ws + WS_CTL + CTL_GW) + (size_t)l * GW_PER_LAYER;
    return which == 0 ? p : which == 1 ? p + NPROJ : which == 2 ? p + 2 * NPROJ : p + 2 * NPROJ + NAB;
}
__device__ __forceinline__ bf16* w_ptr(unsigned char* ws, int l, size_t off) { return (bf16*)(ws + WS_W + (size_t)l * W_LAYER + off); }

__device__ __forceinline__ float wave_sum(float v) {
#pragma unroll
    for (int o = 1; o < 64; o <<= 1) v += __shfl_xor(v, o);
    return v;
}

__device__ __forceinline__ float rt_log_gamma(int h) { return h == 0 ? -0.031748698314580298f : h == 1 ? -0.015748356968139168f : h == 2 ? -0.007843177461025892f : -0.003913899321136329f; }
__device__ __forceinline__ int win_src_col(int np) {
    const int tile = np >> 8, j = np & 255, bj = j >> 7, jj = j & 127;
    if (tile < 4) return bj == 0 ? 128 * tile + jj : 512 + 128 * tile + jj;
    if (tile < 6) return 1024 + 256 * (tile - 4) + j;
    if (tile < 8) return 1536 + 256 * (tile - 6) + j;
    if (tile < 12) { const int base = tile < 10 ? 2048 : 2560, hd = 2 * (tile & 1) + (jj >> 6), i = jj & 63; return base + 128 * hd + 64 * bj + i; }
    if (tile < 14) return 3072 + 256 * (tile - 12) + j;
    return 3584 + 256 * (tile - 14) + j;
}
__device__ __forceinline__ float rope_inv(int i) {
    static const float T[64] = {1.0f, 0.865964353f, 0.749894202f, 0.649381638f, 0.562341332f, 0.486967534f, 0.421696514f, 0.365174115f, 0.316227764f, 0.273841977f, 0.237137377f, 0.2053525f, 0.177827939f, 0.153992653f, 0.133352146f, 0.115478195f, 0.100000001f, 0.0865964293f, 0.0749894232f, 0.0649381652f, 0.0562341325f, 0.0486967526f, 0.0421696492f, 0.0365174115f, 0.0316227749f, 0.0273841955f, 0.0237137377f, 0.0205352511f, 0.0177827943f, 0.0153992651f, 0.013335214f, 0.0115478197f, 0.00999999978f, 0.00865964312f, 0.00749894232f, 0.00649381615f, 0.00562341325f, 0.00486967526f, 0.00421696482f, 0.00365174119f, 0.00316227763f, 0.00273841969f, 0.00237137382f, 0.00205352507f, 0.00177827943f, 0.00153992651f, 0.00133352145f, 0.00115478202f, 0.00100000005f, 0.000865964335f, 0.000749894185f, 0.000649381604f, 0.000562341302f, 0.000486967532f, 0.000421696517f, 0.000365174114f, 0.000316227757f, 0.000273841957f, 0.00023713737f, 0.00020535251f, 0.00017782794f, 0.00015399266f, 0.00013335215f, 0.0001154782f};
    return T[i];
}
__device__ __forceinline__ void tr_item(const float* W, int Nsrc, int scol, const float* gv, const float* bv, bf16* WT, int K, int n0, float* gW, float* bW, LAS float* scr, int k0, int lane) {
    float bacc = 0.f;
#pragma unroll 8
    for (int i = 0; i < 32; ++i) { const int kk = 2 * i + (lane >> 5); float w = W[(size_t)(k0 + kk) * Nsrc + scol];
        if (gv) { bacc += w * bv[k0 + kk]; w *= gv[k0 + kk]; }
        scr[kk * 33 + (lane & 31)] = w; }
    LDS_WAIT(); asm volatile("" ::: "memory");
    const int c = lane & 7;
#pragma unroll
    for (int j = 0; j < 4; ++j) { const int n = (lane >> 3) + 8 * j; const LAS float* s = scr + (8 * c) * 33 + n;
        unsigned h[8]; float gs = 0.f;
#pragma unroll
        for (int e = 0; e < 8; ++e) { h[e] = f2bf(s[e * 33]); gs += bf2f(h[e]); }
        v4u o; o.x = h[0] | (h[1] << 16); o.y = h[2] | (h[3] << 16); o.z = h[4] | (h[5] << 16); o.w = h[6] | (h[7] << 16);
        *(v4u*)(WT + (size_t)(n0 + n) * K + k0 + 8 * c) = o;
        if (gv) { gs += __shfl_xor(gs, 1); gs += __shfl_xor(gs, 2); gs += __shfl_xor(gs, 4); if (c == 0) atomicAdd(gW + n0 + n, gs); } }
    if (gv) { bacc += __shfl_xor(bacc, 32); if (lane < 32) atomicAdd(bW + n0 + lane, bacc); }
    LDS_WAIT(); asm volatile("" ::: "memory");
}
__device__ __forceinline__ void p0_prologue(Frame& F) {
    unsigned char* ws = F.ws;
    LAS float* scr = (LAS float*)(F.lds + F.wave * 16384);
    const int gw = blockIdx.x * NWAVES + F.wave, NGW = gridDim.x * NWAVES, lane = F.lane;
    const int gtid = blockIdx.x * (NWAVES * 64) + F.tid, NT = gridDim.x * NWAVES * 64;
    constexpr int I_IN = 16 * 128, I_O = 16 * 32, I_AB = 16 * 176, I_D = 44 * 32, I_L = I_IN + I_O + I_AB + I_D;
    for (int it = gw; it < DEPTH * I_L; it += NGW) {
        const int l = it / I_L; int r = it - l * I_L;
        if (r < I_IN) { const int kb = r / 128, nb = r % 128, n0 = 32 * nb;
            const float* gv = l ? F.in[I_L2G] + (l - 1) * D : nullptr; const float* bv = l ? F.in[I_L2B] + (l - 1) * D : nullptr;
            tr_item(F.in[I_WIN] + (size_t)l * D * NPROJ, NPROJ, win_src_col(n0 + (lane & 31)), gv, bv, w_ptr(ws, l, W_IN), D, n0, gw_ptr(ws, l, 0), gw_ptr(ws, l, 1), scr, 64 * kb, lane); continue; }
        r -= I_IN;
        if (r < I_O) { const int kb = r / 32, nb = r % 32, n0 = 32 * nb;
            tr_item(F.in[I_WO] + (size_t)l * D * D, D, n0 + (lane & 31), nullptr, nullptr, w_ptr(ws, l, W_O), D, n0, nullptr, nullptr, scr, 64 * kb, lane); continue; }
        r -= I_O;
        if (r < I_AB) { const int kb = r / 176, nb = r % 176, n0 = 32 * nb, tile = n0 >> 8, bj = (n0 >> 7) & 1, jj = (n0 & 127) + (lane & 31);
            const float* W = (bj ? F.in[I_WB] : F.in[I_WA]) + (size_t)l * D * DFF;
            tr_item(W, DFF, 128 * tile + jj, F.in[I_L1G] + l * D, F.in[I_L1B] + l * D, w_ptr(ws, l, W_AB), D, n0, gw_ptr(ws, l, 2), gw_ptr(ws, l, 3), scr, 64 * kb, lane); continue; }
        r -= I_AB;
        { const int kb = r / 32, nb = r % 32, n0 = 32 * nb;
            tr_item(F.in[I_WD] + (size_t)l * DFF * D, D, n0 + (lane & 31), nullptr, nullptr, w_ptr(ws, l, W_DN), DFF, n0, nullptr, nullptr, scr, 64 * kb, lane); }
    }
    float* lb = (float*)(ws + WS_SMALL + SM_LB);
    if (gtid < HGW) { const float* L = F.in[I_LBL]; const float a0 = L[gtid], a1 = L[HGW + gtid], a2 = L[2 * HGW + gtid], a3 = L[3 * HGW + gtid];
        const float mx = fmaxf(fmaxf(a0, a1), fmaxf(a2, a3)); const float e0 = expf(a0 - mx), e1 = expf(a1 - mx), e2 = expf(a2 - mx), e3 = expf(a3 - mx), inv = 1.0f / (e0 + e1 + e2 + e3);
        lb[gtid] = 0.f; lb[HGW + gtid] = e1 * inv; lb[2 * HGW + gtid] = (e1 + e2) * inv; lb[3 * HGW + gtid] = (e1 + e2 + e3) * inv; }
    if (gtid >= 1024 && gtid < 2048) ((float*)(ws + WS_SMALL + SM_ONES))[gtid - 1024] = 1.0f;
    { f32x2* st = stats_ptr(ws, 0); for (int r = gtid; r < MPAD; r += NT) st[r] = (f32x2){0.f, 1024.0f * (1.0f - LN_EPS)}; }
    { f32x2* rope = (f32x2*)(ws + WS_SMALL + SM_ROPE);
      for (int e = gtid; e < NPOS * 64; e += NT) { const int pi = e >> 6, i = e & 63; const int pos = pi < TP ? pi : 16384 + (pi - TP);
          const float ang = (float)pos * rope_inv(i);
          double q = (double)ang * 0.15915494309189535; q -= __builtin_rint(q);
          const float fr = (float)q;
          rope[e] = (f32x2){__builtin_amdgcn_cosf(fr), __builtin_amdgcn_sinf(fr)}; } }
    float* Y = (float*)(ws + WS_Y); bf16* YB = (bf16*)(ws + WS_YB);
    const float* eg = F.in[I_EG]; const float* eb = F.in[I_EB];
    for (int row = gw; row < MPAD; row += NGW) {
        f32x4* yo = (f32x4*)(Y + (size_t)row * D) + lane; v2u* bo = (v2u*)(YB + (size_t)row * D) + lane;
        if (row >= MREAL) {
#pragma unroll
            for (int j = 0; j < 4; ++j) { yo[64 * j] = (f32x4){0.f, 0.f, 0.f, 0.f}; bo[64 * j] = (v2u){0u, 0u}; }
            continue; }
        const float* src;
        if (row < MP) { const int b = row / TP, t = row - b * TP; src = t < NMETA ? F.in[I_META] + (size_t)t * D : F.in[I_XP] + ((size_t)b * SEQP + (t - NMETA)) * D; }
        else src = F.in[I_XS] + (size_t)(row - MP) * D;
        const f32x4* xr = (const f32x4*)src + lane;
        f32x4 v[4]; float s = 0.f;
#pragma unroll
        for (int j = 0; j < 4; ++j) { v[j] = xr[64 * j]; s += (v[j].x + v[j].y) + (v[j].z + v[j].w); }
        const float mean = wave_sum(s) * (1.f / D); float s2 = 0.f;
#pragma unroll
        for (int j = 0; j < 4; ++j) { v[j] = v[j] - mean; s2 += (v[j].x * v[j].x + v[j].y * v[j].y) + (v[j].z * v[j].z + v[j].w * v[j].w); }
        const float rstd = 1.f / sqrtf(wave_sum(s2) * (1.f / D) + LN_EPS);
#pragma unroll
        for (int j = 0; j < 4; ++j) { const f32x4 g = ((const f32x4*)eg)[lane + 64 * j], b = ((const f32x4*)eb)[lane + 64 * j]; const f32x4 y = v[j] * rstd * g + b;
            yo[64 * j] = y; bo[64 * j] = (v2u){pk2(y.x, y.y), pk2(y.z, y.w)}; }
    }
}

using pg8::Unit;
struct EpiIn {
    static constexpr bool PERM = true, AFTER_DRAIN = false;
    const f32x2* st; const float* gW; const float* bW; const float* lb; const f32x2* rope;
    bf16* QT; bf16* KT; bf16* VR; bf16* GT; float* DEC; float* DECS;
    template <int TYPE>
    __device__ __forceinline__ void run(const f32x4 (&acc)[2][2][4][2], const Unit& u, int wr, int wc, int fr, int fq) const {
        const int pn = u.pn, jj0 = wc * 32 + 8 * fq;
        f32x4 lbv[2] = {(f32x4){0.f, 0.f, 0.f, 0.f}, (f32x4){0.f, 0.f, 0.f, 0.f}};
        if (TYPE == 0) { lbv[0] = *(const f32x4*)(lb + 128 * pn + jj0); lbv[1] = *(const f32x4*)(lb + 128 * pn + jj0 + 4); }
        const int hd = 2 * (pn & 1) + (jj0 >> 6), i0 = jj0 & 63;
        const float lg = rt_log_gamma(hd);
        const int cb12 = ((pn & 8) ? 512 : 0) + 256 * (pn & 1);
#pragma unroll
        for (int ai = 0; ai < 2; ++ai) {
            const int rowbase = u.pm * 256 + ai * 128 + wr * 64;
            const bool smp = rowbase >= MP;
            const int tau = smp ? (fr & 3) : fr;
#pragma unroll
            for (int m = 0; m < 4; ++m) {
                const int row = rowbase + 16 * m + fr;
                const f32x2 s = st[row]; const float mu = s.x * (1.f / D), rstd = rsqrtf(s.y * (1.f / D) - mu * mu + LN_EPS);
                f32x4 v[2][2];
#pragma unroll
                for (int bj = 0; bj < 2; ++bj)
#pragma unroll
                    for (int n = 0; n < 2; ++n) { const f32x4 gwv = *(const f32x4*)(gW + 256 * pn + 128 * bj + jj0 + 4 * n), bwv = *(const f32x4*)(bW + 256 * pn + 128 * bj + jj0 + 4 * n);
                        v[bj][n] = (acc[ai][bj][m][n] - mu * gwv) * rstd + bwv; }
                if (TYPE == 0) {
                    float qt[8], kt[8], bb[8];
#pragma unroll
                    for (int n = 0; n < 2; ++n)
#pragma unroll
                        for (int i = 0; i < 4; ++i) { const float hq = v[0][n][i], hf = v[1][n][i], l0 = lbv[n][i];
                            const float sg = sigmoidf_(hf), f = l0 + (1.f - l0) * sg; float b = __logf(fmaxf(f, F_EPS));
                            const float kk = (1.f - l0) * (1.f - sg), q = hq * sigmoidf_(hq);
                            { float y = __shfl_up(b, 1, 16); if (tau >= 1) b += y; y = __shfl_up(b, 2, 16); if (tau >= 2) b += y;
                              if (!smp) { y = __shfl_up(b, 4, 16); if (tau >= 4) b += y; y = __shfl_up(b, 8, 16); if (tau >= 8) b += y; } }
                            bb[4 * n + i] = b; qt[4 * n + i] = q * __expf(b); kt[4 * n + i] = kk * __expf(-b); }
                    const size_t o = (size_t)row * D + 128 * pn + jj0;
                    *(v4u*)(QT + o) = (v4u){pk2(qt[0], qt[1]), pk2(qt[2], qt[3]), pk2(qt[4], qt[5]), pk2(qt[6], qt[7])};
                    *(v4u*)(KT + o) = (v4u){pk2(kt[0], kt[1]), pk2(kt[2], kt[3]), pk2(kt[4], kt[5]), pk2(kt[6], kt[7])};
                    if (!smp) { if (fr == 15) { float* d = DEC + (size_t)(row >> 4) * HGW + 128 * pn + jj0; *(f32x4*)d = (f32x4){bb[0], bb[1], bb[2], bb[3]}; *(f32x4*)(d + 4) = (f32x4){bb[4], bb[5], bb[6], bb[7]}; } }
                    else if ((fr & 3) == 3) { float* d = DECS + (size_t)((row - MP) >> 2) * HGW + 128 * pn + jj0; *(f32x4*)d = (f32x4){bb[0], bb[1], bb[2], bb[3]}; *(f32x4*)(d + 4) = (f32x4){bb[4], bb[5], bb[6], bb[7]}; }
                } else if (TYPE == 1 || TYPE == 2) {
                    bf16* dst = (TYPE == 1 ? VR : GT) + (size_t)row * D + cb12 + jj0;
#pragma unroll
                    for (int bj = 0; bj < 2; ++bj) { f32x4 a = v[bj][0], b = v[bj][1];
                        if (TYPE == 2) {
#pragma unroll
                            for (int i = 0; i < 4; ++i) { a[i] = a[i] * sigmoidf_(a[i]); b[i] = b[i] * sigmoidf_(b[i]); } }
                        *(v4u*)(dst + 128 * bj) = (v4u){pk2(a[0], a[1]), pk2(a[2], a[3]), pk2(b[0], b[1]), pk2(b[2], b[3])}; }
                } else {
                    const int pi = smp ? TP + ((row - MP) & 3) : row - TP * (row / TP);
                    const f32x4* cs = (const f32x4*)(rope + (size_t)pi * 64 + i0);
                    const float sc = TYPE == 3 ? __expf((float)(tau + 1) * lg) : RT_KSCALE * __expf(-(float)(tau + 1) * lg);
                    float o1[8], o2[8];
#pragma unroll
                    for (int p = 0; p < 4; ++p) { const f32x4 c2 = cs[p];
#pragma unroll
                        for (int e = 0; e < 2; ++e) { const int j = 2 * p + e; const float c = c2[2 * e], sn = c2[2 * e + 1], x1 = v[0][j >> 2][j & 3], x2 = v[1][j >> 2][j & 3];
                            o1[j] = (x1 * c - x2 * sn) * sc; o2[j] = (x1 * sn + x2 * c) * sc; } }
                    bf16* dst = (TYPE == 3 ? QT : KT) + (size_t)row * D + HGW + 128 * hd + i0;
                    *(v4u*)dst = (v4u){pk2(o1[0], o1[1]), pk2(o1[2], o1[3]), pk2(o1[4], o1[5]), pk2(o1[6], o1[7])};
                    *(v4u*)(dst + 64) = (v4u){pk2(o2[0], o2[1]), pk2(o2[2], o2[3]), pk2(o2[4], o2[5]), pk2(o2[6], o2[7])};
                }
                asm volatile("" ::: "memory");
            }
        }
    }
    __device__ __forceinline__ void operator()(const f32x4 (&acc)[2][2][4][2], const Unit& u, int wr, int wc, int fr, int fq) const {
        const int pn = u.pn;
        if (pn < 4) run<0>(acc, u, wr, wc, fr, fq);
        else if (pn == 4 || pn == 5 || pn == 12 || pn == 13) run<1>(acc, u, wr, wc, fr, fq);
        else if (pn == 6 || pn == 7 || pn >= 14) run<2>(acc, u, wr, wc, fr, fq);
        else if (pn < 10) run<3>(acc, u, wr, wc, fr, fq);
        else run<4>(acc, u, wr, wc, fr, fq);
    }
};
struct EpiRes {
    static constexpr bool PERM = false, AFTER_DRAIN = false;
    const float* Yin; float* Yout; bf16* YB; const f32x2* st_in; const float* g; const float* b; f32x2* st_out;
    __device__ __forceinline__ void operator()(const f32x4 (&acc)[2][2][4][2], const Unit& u, int wr, int wc, int fr, int fq) const {
        const int col0 = u.pn * 256 + wc * 32 + 4 * fq;
        f32x4 gv[2][2], bv[2][2];
#pragma unroll
        for (int bj = 0; bj < 2; ++bj)
#pragma unroll
            for (int n = 0; n < 2; ++n) { gv[bj][n] = *(const f32x4*)(g + col0 + 128 * bj + 16 * n); bv[bj][n] = *(const f32x4*)(b + col0 + 128 * bj + 16 * n); }
#pragma unroll
        for (int ai = 0; ai < 2; ++ai)
#pragma unroll
            for (int m = 0; m < 4; ++m) {
                const int row = u.pm * 256 + ai * 128 + wr * 64 + 16 * m + fr;
                const f32x2 s = st_in[row]; const float mu = s.x * (1.f / D), rstd = rsqrtf(s.y * (1.f / D) - mu * mu + LN_EPS);
                const size_t off = (size_t)row * D + col0; float sy = 0.f, sq = 0.f;
#pragma unroll
                for (int bj = 0; bj < 2; ++bj)
#pragma unroll
                    for (int n = 0; n < 2; ++n) { const f32x4 yi = *(const f32x4*)(Yin + off + 128 * bj + 16 * n);
                        const f32x4 x = (yi - mu) * rstd * gv[bj][n] + bv[bj][n]; const f32x4 y = ALPHA * x + acc[ai][bj][m][n];
                        *(f32x4*)(Yout + off + 128 * bj + 16 * n) = y; *(v2u*)(YB + off + 128 * bj + 16 * n) = (v2u){pk2(y[0], y[1]), pk2(y[2], y[3])};
                        sy += (y[0] + y[1]) + (y[2] + y[3]); sq += (y[0] * y[0] + y[1] * y[1]) + (y[2] * y[2] + y[3] * y[3]); }
                sy += __shfl_xor(sy, 16); sy += __shfl_xor(sy, 32); sq += __shfl_xor(sq, 16); sq += __shfl_xor(sq, 32);
                if (fq == 0) { float* so = (float*)(st_out + row); atomicAdd(so, sy); atomicAdd(so + 1, sq); }
                if (m & 1) asm volatile("" ::: "memory");
            }
    }
};
struct EpiUp {
    static constexpr bool PERM = true, AFTER_DRAIN = false;
    const f32x2* st; const float* gW; const float* bW; bf16* A; bf16* G;
    __device__ __forceinline__ void operator()(const f32x4 (&acc)[2][2][4][2], const Unit& u, int wr, int wc, int fr, int fq) const {
        const int pn = u.pn, jj0 = wc * 32 + 8 * fq;
        f32x4 gw[2][2], bw[2][2];
#pragma unroll
        for (int bj = 0; bj < 2; ++bj)
#pragma unroll
            for (int n = 0; n < 2; ++n) { gw[bj][n] = *(const f32x4*)(gW + 256 * pn + 128 * bj + jj0 + 4 * n); bw[bj][n] = *(const f32x4*)(bW + 256 * pn + 128 * bj + jj0 + 4 * n); }
#pragma unroll
        for (int ai = 0; ai < 2; ++ai)
#pragma unroll
            for (int m = 0; m < 4; ++m) {
                const int row = u.pm * 256 + ai * 128 + wr * 64 + 16 * m + fr;
                const f32x2 s = st[row]; const float mu = s.x * (1.f / D), rstd = rsqrtf(s.y * (1.f / D) - mu * mu + LN_EPS);
                const size_t o = (size_t)row * DFF + 128 * pn + jj0;
#pragma unroll
                for (int bj = 0; bj < 2; ++bj) { const f32x4 a = (acc[ai][bj][m][0] - mu * gw[bj][0]) * rstd + bw[bj][0], b = (acc[ai][bj][m][1] - mu * gw[bj][1]) * rstd + bw[bj][1];
                    *(v4u*)((bj ? G : A) + o) = (v4u){pk2(a[0], a[1]), pk2(a[2], a[3]), pk2(b[0], b[1]), pk2(b[2], b[3])}; }
            }
    }
};

__device__ __forceinline__ void mixer_naive(Frame& F, int l) {
    unsigned char* ws = F.ws;
    const int tid = F.tid, v = tid & 127, kq = tid >> 7;
    LAS unsigned char* L = F.lds;
    LAS bf16* TL = (LAS bf16*)L;
    LAS float* Es = (LAS float*)(L + 16384);
    LAS float* OP = (LAS float*)(L + 16384 + 512);
    const bf16* QT = (const bf16*)(ws + WS_R + R_QT); const bf16* KT = (const bf16*)(ws + WS_R + R_KT); const bf16* VR = (const bf16*)(ws + WS_R + R_VR); const bf16* GT = (const bf16*)(ws + WS_R + R_GT);
    bf16* O = (bf16*)(ws + WS_R + R_O);
    const float* DEC = (const float*)(ws + WS_R + R_DEC); const float* DECS = (const float*)(ws + WS_R + R_DECS);
    const int w = blockIdx.x;
    for (int it = 0;; ++it) {
        bool smp; int seq, H, nchunks, ntok, row_base;
        if (w < 64) { if (it > 0) break; smp = false; seq = w >> 3; H = w & 7; nchunks = TP / 16; ntok = 16; row_base = seq * TP; }
        else { const int id = (w - 64) + (int)(gridDim.x - 64) * it; if (id >= NS * 8) break; smp = true; seq = id >> 3; H = id & 7; nchunks = 1; ntok = 4; row_base = MP + 4 * seq; }
        const bool hg = H < 4; const int h = H & 3;
        float Z[32];
        if (smp) { const float* S0 = (hg ? F.in[I_SHG] : F.in[I_SRT]) + (((size_t)l * NS + seq) * 4 + h) * 16384;
#pragma unroll
            for (int j = 0; j < 32; ++j) Z[j] = S0[(kq * 32 + j) * 128 + v]; }
        else {
#pragma unroll
            for (int j = 0; j < 32; ++j) Z[j] = 0.f; }
        const float lg = rt_log_gamma(h), Eret = __expf(lg * (float)ntok);
        const float* nrm_g = hg ? F.in[I_HGN] + l * HGW + 128 * h : F.in[I_GNG] + l * HGW + 128 * h;
        const float* nrm_b = F.in[I_GNB] + l * HGW + 128 * h;
        for (int c = 0; c < nchunks; ++c) {
            const int row0 = row_base + 16 * c;
            { const int tile = tid >> 7, p = tid & 127; const bf16* src = tile == 0 ? QT : tile == 1 ? KT : tile == 2 ? VR : GT;
#pragma unroll
              for (int rr = 0; rr < 2; ++rr) { const int r = (p >> 4) + 8 * rr; v4u x = (v4u){0u, 0u, 0u, 0u};
                  if (r < ntok) x = *(const v4u*)(src + (size_t)(row0 + r) * D + 128 * H + (p & 15) * 8);
                  *(LAS v4u*)(TL + tile * 2048 + r * 128 + (p & 15) * 8) = x; } }
            if (tid < 128) Es[tid] = hg ? __expf(smp ? DECS[(size_t)seq * HGW + 128 * h + tid] : DEC[(size_t)(row0 >> 4) * HGW + 128 * h + tid]) : Eret;
            __syncthreads();
            for (int t = 0; t < ntok; ++t) {
                const float vv = bf2f(TL[2 * 2048 + t * 128 + v]);
                float op = 0.f;
#pragma unroll
                for (int j4 = 0; j4 < 4; ++j4) { const v4u kw = *(const LAS v4u*)(TL + 2048 + t * 128 + kq * 32 + 8 * j4), qw = *(const LAS v4u*)(TL + t * 128 + kq * 32 + 8 * j4);
#pragma unroll
                    for (int e = 0; e < 4; ++e) { const unsigned ku = kw[e], qu = qw[e];
                        Z[8 * j4 + 2 * e] = fmaf(bflo(ku), vv, Z[8 * j4 + 2 * e]); op = fmaf(Z[8 * j4 + 2 * e], bflo(qu), op);
                        Z[8 * j4 + 2 * e + 1] = fmaf(bfhi(ku), vv, Z[8 * j4 + 2 * e + 1]); op = fmaf(Z[8 * j4 + 2 * e + 1], bfhi(qu), op); } }
                OP[(t * 4 + kq) * 128 + v] = op;
            }
            __syncthreads();
            { const int tt = tid >> 5, v4 = (tid & 31) * 4;
              f32x4 o = (f32x4){0.f, 0.f, 0.f, 0.f};
              if (tt < ntok) {
#pragma unroll
                  for (int q = 0; q < 4; ++q) o += *(const LAS f32x4*)(OP + (tt * 4 + q) * 128 + v4); }
              float s = (o[0] + o[1]) + (o[2] + o[3]), ss = (o[0] * o[0] + o[1] * o[1]) + (o[2] * o[2] + o[3] * o[3]);
#pragma unroll
              for (int x = 1; x < 32; x <<= 1) { s += __shfl_xor(s, x); ss += __shfl_xor(ss, x); }
              const v2u gwd = *(const LAS v2u*)(TL + 3 * 2048 + tt * 128 + v4);
              const float gt[4] = {bflo(gwd.x), bfhi(gwd.x), bflo(gwd.y), bfhi(gwd.y)};
              const f32x4 ng = *(const f32x4*)(nrm_g + v4);
              float r[4];
              if (hg) { const float rs = rsqrtf(ss * (1.f / 128.f) + LN_EPS);
#pragma unroll
                  for (int i = 0; i < 4; ++i) r[i] = o[i] * rs * ng[i] * gt[i]; }
              else { const f32x4 nb = *(const f32x4*)(nrm_b + v4); const float mean = s * (1.f / 128.f), rs = rsqrtf(ss * (1.f / 128.f) - mean * mean + LN_EPS);
#pragma unroll
                  for (int i = 0; i < 4; ++i) r[i] = ((o[i] - mean) * rs * ng[i] + nb[i]) * gt[i]; }
              if (tt < ntok) *(v2u*)(O + (size_t)(row0 + tt) * D + 128 * H + v4) = (v2u){pk2(r[0], r[1]), pk2(r[2], r[3])}; }
#pragma unroll
            for (int j = 0; j < 32; ++j) Z[j] *= Es[kq * 32 + j];
            __syncthreads();
        }
        float* dst = F.out + (smp ? (hg ? O_HS : O_RS) + (((size_t)l * NS + seq) * 4 + h) * 16384 : (hg ? O_HP : O_RP) + (((size_t)l * NB + seq) * 4 + h) * 16384);
#pragma unroll
        for (int j = 0; j < 32; ++j) dst[(kq * 32 + j) * 128 + v] = Z[j];
    }
}

typedef short bf16x8_t __attribute__((ext_vector_type(8)));
typedef short s16x4_t __attribute__((ext_vector_type(4)));
constexpr int MX_ROWB = 288;
constexpr int MX_ROWR = 264;
constexpr int MX_OP = 132;
constexpr int MX_TQ = 0, MX_TKR = MX_TQ + 64 * MX_ROWR, MX_TK = MX_TKR + 64 * MX_ROWR, MX_TV = MX_TK + 64 * MX_ROWB, MX_ES = MX_TV + 64 * MX_ROWB, MX_TO = MX_ES + 4 * 128 * 4, MX_NG = MX_TO + 64 * MX_OP * 4, MX_END = MX_NG + 2 * 128 * 4;
static_assert(MX_END <= RING_BYTES && MX_TK % 16 == 0 && MX_TO % 16 == 0, "mixer LDS");
__device__ __forceinline__ bf16x8_t mx_ld2(LAS unsigned char* p) { const v2u lo = *(const LAS v2u*)p, hi = *(const LAS v2u*)(p + 32); return __builtin_bit_cast(bf16x8_t, (v4u){lo.x, lo.y, hi.x, hi.y}); }
__device__ __forceinline__ s16x4_t mx_tr4(LAS unsigned char* p) { return __builtin_amdgcn_ds_read_tr16_b64_v4i16((LAS s16x4_t*)p); }
__device__ __forceinline__ bf16x8_t mx_pad(s16x4_t r) { return (bf16x8_t){r[0], r[1], r[2], r[3], 0, 0, 0, 0}; }
__device__ __forceinline__ float dpp_sum8(float x) {
    x += __builtin_bit_cast(float, __builtin_amdgcn_update_dpp(0, __builtin_bit_cast(int, x), 0xB1, 0xF, 0xF, true));
    x += __builtin_bit_cast(float, __builtin_amdgcn_update_dpp(0, __builtin_bit_cast(int, x), 0x4E, 0xF, 0xF, true));
    x += __builtin_bit_cast(float, __builtin_amdgcn_update_dpp(0, __builtin_bit_cast(int, x), 0x141, 0xF, 0xF, true));
    return x;
}
__device__ __forceinline__ void mixer_mfma(Frame& F, int l) {
    unsigned char* ws = F.ws;
    const int tid = F.tid, lane = F.lane, wave = F.wave, l15 = lane & 15, g = lane >> 4, v0 = 16 * wave;
    LAS unsigned char* L = F.lds;
    const bf16* QT = (const bf16*)(ws + WS_R + R_QT); const bf16* KT = (const bf16*)(ws + WS_R + R_KT); const bf16* VR = (const bf16*)(ws + WS_R + R_VR); const bf16* GT = (const bf16*)(ws + WS_R + R_GT);
    bf16* O = (bf16*)(ws + WS_R + R_O);
    const float* DEC = (const float*)(ws + WS_R + R_DEC); const float* DECS = (const float*)(ws + WS_R + R_DECS);
    const int w = blockIdx.x;
    const int qrow_off = l15 * MX_ROWR + 8 * g;
    const int tr_off = (4 * g + (l15 >> 2)) * MX_ROWB + 8 * (l15 & 3);
    const int ftok = tid >> 3, fsg = tid & 7;
    for (int it = 0;; ++it) {
        bool smp; int seq, H, nchunks, ntok, row_base;
        if (w < 64) { if (it > 0) break; smp = false; seq = w >> 3; H = w & 7; nchunks = TP / 16; ntok = 16; row_base = seq * TP; }
        else { const int id = (w - 64) + (int)(gridDim.x - 64) * it; if (id >= NS * 8) break; smp = true; seq = id >> 3; H = id & 7; nchunks = 1; ntok = 4; row_base = MP + 4 * seq; }
        const bool hg = H < 4; const int h = H & 3;
        const int nst = (nchunks + 3) >> 2;
        f32x4 Z[8];
        if (smp) { const float* S0 = (hg ? F.in[I_SHG] : F.in[I_SRT]) + (((size_t)l * NS + seq) * 4 + h) * 16384 + v0 + l15 + 4 * g * 128;
#pragma unroll
            for (int kb = 0; kb < 8; ++kb) { unsigned zo = 16 * 128 * kb; asm volatile("" : "+v"(zo));
#pragma unroll
                for (int r = 0; r < 4; ++r) Z[kb][r] = S0[zo + r * 128]; } }
        else {
#pragma unroll
            for (int kb = 0; kb < 8; ++kb) Z[kb] = (f32x4){0.f, 0.f, 0.f, 0.f}; }
        const float lg = rt_log_gamma(h), Eret = __expf(lg * (float)ntok);
        v4u RQ[2], RK[2], RV[2], RGa, RGb; float RE = 0.f;
#define MX_LOADS(s_) do { const int rb_ = row_base + 64 * (s_); \
            _Pragma("unroll") for (int j_ = 0; j_ < 2; ++j_) { const int id_ = tid + 512 * j_, rr_ = id_ >> 4, cc_ = id_ & 15; \
                if ((rr_ & 15) < ntok && (rr_ >> 4) < nchunks - 4 * (s_)) { const size_t o_ = (size_t)(rb_ + rr_) * D + 128 * H + 8 * cc_; \
                    RQ[j_] = *(const v4u*)(QT + o_); RK[j_] = *(const v4u*)(KT + o_); RV[j_] = *(const v4u*)(VR + o_); } \
                else { RQ[j_] = (v4u){0u, 0u, 0u, 0u}; RK[j_] = RQ[j_]; RV[j_] = RQ[j_]; } } \
            if (hg) { const int c_ = tid >> 7, k_ = tid & 127; RE = smp ? DECS[(size_t)seq * HGW + 128 * h + k_] : ((4 * (s_) + c_) < nchunks ? DEC[(size_t)((row_base >> 4) + 4 * (s_) + c_) * HGW + 128 * h + k_] : 0.f); } } while (0)
#define MX_WRITE(s_) do { \
            _Pragma("unroll") for (int j_ = 0; j_ < 2; ++j_) { const int id_ = tid + 512 * j_, rr_ = id_ >> 4, cc_ = id_ & 15; const int o_ = rr_ * MX_ROWB + 16 * cc_, or_ = rr_ * MX_ROWR + 16 * cc_; \
                *(LAS v2u*)(L + MX_TQ + or_) = (v2u){RQ[j_].x, RQ[j_].y}; *(LAS v2u*)(L + MX_TQ + or_ + 8) = (v2u){RQ[j_].z, RQ[j_].w}; \
                *(LAS v2u*)(L + MX_TKR + or_) = (v2u){RK[j_].x, RK[j_].y}; *(LAS v2u*)(L + MX_TKR + or_ + 8) = (v2u){RK[j_].z, RK[j_].w}; \
                *(LAS v4u*)(L + MX_TK + o_) = RK[j_]; *(LAS v4u*)(L + MX_TV + o_) = RV[j_]; } \
            ((LAS float*)(L + MX_ES))[tid] = hg ? __expf(RE) : Eret; } while (0)
        MX_LOADS(0);
        __syncthreads();
        MX_WRITE(0);
        if (tid < 128) { ((LAS float*)(L + MX_NG))[tid] = (hg ? F.in[I_HGN] : F.in[I_GNG])[l * HGW + 128 * h + tid]; ((LAS float*)(L + MX_NG))[128 + tid] = hg ? 0.f : F.in[I_GNB][l * HGW + 128 * h + tid]; }
        __syncthreads();
        for (int s = 0; s < nst; ++s) {
            const int nch = (nchunks - 4 * s) < 4 ? (nchunks - 4 * s) : 4;
            const bool fvalid = (ftok >> 4) < nch && (ftok & 15) < ntok;
            if (s + 1 < nst) MX_LOADS(s + 1);
#pragma unroll 1
            for (int c = 0; c < nch; ++c) {
                LAS unsigned char* tq = L + MX_TQ + c * 16 * MX_ROWR; LAS unsigned char* tkr = L + MX_TKR + c * 16 * MX_ROWR; LAS unsigned char* tk = L + MX_TK + c * 16 * MX_ROWB; LAS unsigned char* tv = L + MX_TV + c * 16 * MX_ROWB;
                bf16x8_t QA[4], KR[4]; s16x4_t KTr[8]; f32x4 EE[8];
#pragma unroll
                for (int ks = 0; ks < 4; ++ks) { QA[ks] = mx_ld2(tq + qrow_off + 64 * ks); KR[ks] = mx_ld2(tkr + qrow_off + 64 * ks); }
                const s16x4_t vt = mx_tr4(tv + tr_off + 2 * v0);
#pragma unroll
                for (int kb = 0; kb < 8; ++kb) KTr[kb] = mx_tr4(tk + tr_off + 32 * kb);
#pragma unroll
                for (int kb = 0; kb < 8; ++kb) EE[kb] = *(const LAS f32x4*)(L + MX_ES + (c * 128 + 16 * kb + 4 * g) * 4);
                __builtin_amdgcn_sched_barrier(0);
                f32x4 pt = (f32x4){0.f, 0.f, 0.f, 0.f};
#pragma unroll
                for (int ks = 0; ks < 4; ++ks) pt = __builtin_amdgcn_mfma_f32_16x16x32_bf16(KR[ks], QA[ks], pt, 0, 0, 0);
#pragma unroll
                for (int r = 0; r < 4; ++r) pt[r] = (4 * g + r <= l15) ? pt[r] : 0.f;
                const bf16x8_t PA = __builtin_bit_cast(bf16x8_t, (v4u){pk2(pt[0], pt[1]), pk2(pt[2], pt[3]), 0u, 0u});
                const bf16x8_t VB = mx_pad(vt);
                f32x4 o = __builtin_amdgcn_mfma_f32_16x16x32_bf16(PA, VB, (f32x4){0.f, 0.f, 0.f, 0.f}, 0, 0, 0);
#pragma unroll
                for (int ks = 0; ks < 4; ++ks) { const bf16x8_t ZB = __builtin_bit_cast(bf16x8_t, (v4u){pk2(Z[2 * ks][0], Z[2 * ks][1]), pk2(Z[2 * ks][2], Z[2 * ks][3]), pk2(Z[2 * ks + 1][0], Z[2 * ks + 1][1]), pk2(Z[2 * ks + 1][2], Z[2 * ks + 1][3])});
                    o = __builtin_amdgcn_mfma_f32_16x16x32_bf16(QA[ks], ZB, o, 0, 0, 0); }
#pragma unroll
                for (int kb = 0; kb < 8; ++kb) Z[kb] = __builtin_amdgcn_mfma_f32_16x16x32_bf16(mx_pad(KTr[kb]), VB, Z[kb], 0, 0, 0);
#pragma unroll
                for (int kb = 0; kb < 8; ++kb) Z[kb] *= EE[kb];
                LAS float* to = (LAS float*)(L + MX_TO) + (c * 16 + 4 * g) * MX_OP + v0 + l15;
#pragma unroll
                for (int r = 0; r < 4; ++r) to[r * MX_OP] = o[r];
            }
            __syncthreads();
            { const size_t o_ = (size_t)(row_base + 64 * s + (fvalid ? ftok : 0)) * D + 128 * H + 16 * fsg; RGa = *(const v4u*)(GT + o_); RGb = *(const v4u*)(GT + o_ + 8); }
            if (s + 1 < nst) MX_WRITE(s + 1);
            {
                const LAS f32x4* op = (const LAS f32x4*)((LAS float*)(L + MX_TO) + ftok * MX_OP + 16 * fsg);
                f32x4 ov[4]; float s1 = 0.f, s2 = 0.f;
#pragma unroll
                for (int q = 0; q < 4; ++q) { ov[q] = op[q]; s1 += (ov[q][0] + ov[q][1]) + (ov[q][2] + ov[q][3]); s2 += (ov[q][0] * ov[q][0] + ov[q][1] * ov[q][1]) + (ov[q][2] * ov[q][2] + ov[q][3] * ov[q][3]); }
                s1 = dpp_sum8(s1); s2 = dpp_sum8(s2);
                const float mean = hg ? 0.f : s1 * (1.f / 128.f); const float rs = rsqrtf(s2 * (1.f / 128.f) - mean * mean + LN_EPS);
                const unsigned gw_[8] = {RGa.x, RGa.y, RGa.z, RGa.w, RGb.x, RGb.y, RGb.z, RGb.w};
                unsigned ow[8];
#pragma unroll
                for (int q = 0; q < 4; ++q) { const f32x4 ngv = *(const LAS f32x4*)(L + MX_NG + (16 * fsg + 4 * q) * 4), nbv = *(const LAS f32x4*)(L + MX_NG + (128 + 16 * fsg + 4 * q) * 4);
                    const f32x4 y = ((ov[q] - mean) * rs * ngv + nbv);
                    ow[2 * q] = pk2(y[0] * bflo(gw_[2 * q]), y[1] * bfhi(gw_[2 * q])); ow[2 * q + 1] = pk2(y[2] * bflo(gw_[2 * q + 1]), y[3] * bfhi(gw_[2 * q + 1])); }
                if (fvalid) { bf16* dst = O + (size_t)(row_base + 64 * s + ftok) * D + 128 * H + 16 * fsg;
                    *(v4u*)dst = (v4u){ow[0], ow[1], ow[2], ow[3]}; *(v4u*)(dst + 8) = (v4u){ow[4], ow[5], ow[6], ow[7]}; }
            }
            __syncthreads();
        }
        float* dst = F.out + (smp ? (hg ? O_HS : O_RS) + (((size_t)l * NS + seq) * 4 + h) * 16384 : (hg ? O_HP : O_RP) + (((size_t)l * NB + seq) * 4 + h) * 16384) + v0 + l15 + 4 * g * 128;
#pragma unroll
        for (int kb = 0; kb < 8; ++kb) { unsigned zo = 16 * 128 * kb; asm volatile("" : "+v"(zo));
#pragma unroll
            for (int r = 0; r < 4; ++r) dst[zo + r * 128] = Z[kb][r]; }
#undef MX_LOADS
#undef MX_WRITE
    }
}

__device__ __forceinline__ void unpack8(const v4u w, float (&f)[8]) {
#pragma unroll
    for (int e = 0; e < 4; ++e) { f[2 * e] = bflo(w[e]); f[2 * e + 1] = bfhi(w[e]); }
}
__device__ __forceinline__ float gelu_tanh(float x) { const float u = 0.7978845608028654f * (x + 0.044715f * x * x * x); return x / (1.0f + __expf(-2.0f * u)); }
__device__ __forceinline__ void conv_phase(Frame& F, int l) {
    unsigned char* ws = F.ws;
    const bf16* A = (const bf16*)(ws + WS_R + R_A); bf16* G = (bf16*)(ws + WS_R + R_G);
    const float* cw = F.in[I_CW] + (size_t)l * 3 * DFF; const float* cb = F.in[I_CB] + (size_t)l * DFF;
    const float* scv = F.in[I_SCV] + (size_t)l * NS * 2 * DFF;
    float* ocp = F.out + O_CP + (size_t)l * NB * 2 * DFF; float* ocs = F.out + O_CS + (size_t)l * NS * 2 * DFF;
    constexpr int FG = DFF / 8  , NRC = MPAD / 16  ;
    const int gtid = blockIdx.x * (NWAVES * 64) + F.tid, NT = gridDim.x * NWAVES * 64;
    for (int item = gtid; item < NRC * FG; item += NT) {
        const int rc = item / FG, fg = item - rc * FG, f0 = fg * 8, row0 = rc * 16;
        if (row0 >= MREAL) { for (int r = 0; r < 16; ++r) *(v4u*)(G + (size_t)(row0 + r) * DFF + f0) = (v4u){0u, 0u, 0u, 0u}; continue; }
        float w0[8], w1[8], w2[8], bb[8];
#pragma unroll
        for (int e = 0; e < 8; ++e) { w0[e] = cw[f0 + e]; w1[e] = cw[DFF + f0 + e]; w2[e] = cw[2 * DFF + f0 + e]; bb[e] = cb[f0 + e]; }
        const bool smp = row0 >= MP;
        float a1[8], a2[8];
        const int tseq = smp ? 0 : row0 - TP * (row0 / TP);
        if (!smp && tseq > 0) { unpack8(*(const v4u*)(A + (size_t)(row0 - 1) * DFF + f0), a1); unpack8(*(const v4u*)(A + (size_t)(row0 - 2) * DFF + f0), a2); }
        else {
#pragma unroll
            for (int e = 0; e < 8; ++e) { a1[e] = 0.f; a2[e] = 0.f; } }
        for (int r = 0; r < 16; ++r) {
            const int row = row0 + r;
            if (smp && (r & 3) == 0) { const int s = (row - MP) >> 2;
#pragma unroll
                for (int e = 0; e < 8; ++e) { a2[e] = scv[((size_t)s * 2 + 0) * DFF + f0 + e]; a1[e] = scv[((size_t)s * 2 + 1) * DFF + f0 + e]; } }
            float a0[8], g[8], hh[8];
            unpack8(*(const v4u*)(A + (size_t)row * DFF + f0), a0); unpack8(*(const v4u*)(G + (size_t)row * DFF + f0), g);
#pragma unroll
            for (int e = 0; e < 8; ++e) { const float cv = bb[e] + w0[e] * a2[e] + w1[e] * a1[e] + w2[e] * a0[e]; hh[e] = gelu_tanh(cv) * g[e]; }
            *(v4u*)(G + (size_t)row * DFF + f0) = (v4u){pk2(hh[0], hh[1]), pk2(hh[2], hh[3]), pk2(hh[4], hh[5]), pk2(hh[6], hh[7])};
            if (!smp) { const int t = tseq + r; if (t >= TP - 2) { float* d = ocp + ((size_t)(row0 / TP) * 2 + (t - (TP - 2))) * DFF + f0;
#pragma unroll
                    for (int e = 0; e < 8; ++e) d[e] = a0[e]; } }
            else if ((r & 3) >= 2) { float* d = ocs + ((size_t)((row - MP) >> 2) * 2 + ((r & 3) - 2)) * DFF + f0;
#pragma unroll
                for (int e = 0; e < 8; ++e) d[e] = a0[e]; }
#pragma unroll
            for (int e = 0; e < 8; ++e) { a2[e] = a1[e]; a1[e] = a0[e]; }
        }
    }
}

__device__ __forceinline__ void final_phase(Frame& F) {
    unsigned char* ws = F.ws;
    const float* Y = (const float*)(ws + WS_Y); const f32x2* st = stats_ptr(ws, 4);
    const float* g = F.in[I_L2G] + 3 * D; const float* b = F.in[I_L2B] + 3 * D;
    const int gw = blockIdx.x * NWAVES + F.wave, NGW = gridDim.x * NWAVES, lane = F.lane;
    for (int row = gw; row < MREAL; row += NGW) {
        float* dst;
        if (row < MP) { const int bb = row / TP, t = row - bb * TP; if (t < NMETA) continue; dst = F.out + O_YP + ((size_t)bb * SEQP + (t - NMETA)) * D; }
        else dst = F.out + O_YS + (size_t)(row - MP) * D;
        const f32x2 s = st[row]; const float mu = s.x * (1.f / D), rstd = rsqrtf(s.y * (1.f / D) - mu * mu + LN_EPS);
#pragma unroll
        for (int j = 0; j < 4; ++j) { const f32x4 y = ((const f32x4*)(Y + (size_t)row * D))[lane + 64 * j]; const f32x4 gg = ((const f32x4*)g)[lane + 64 * j], bb = ((const f32x4*)b)[lane + 64 * j];
            ((f32x4*)dst)[lane + 64 * j] = (y - mu) * rstd * gg + bb; }
    }
}

#ifndef ONE_LAUNCH
#define ONE_LAUNCH 1
#endif
constexpr int NPHASES = 2 + 6 * DEPTH;
struct Args { const float* in[23]; float* out; unsigned char* ws; int ph_lo, ph_hi; };
template <int ONLY_SUB> __global__ void __launch_bounds__(NWAVES * 64, 2) hymba_fwd(Args args) {
    extern __shared__ __attribute__((aligned(16))) unsigned char lds[];
    Frame F;
    F.lds = (LAS unsigned char*)lds;
    F.tid = threadIdx.x; F.lane = F.tid & 63; F.wave = __builtin_amdgcn_readfirstlane(F.tid >> 6);
    F.in = args.in; F.out = args.out; F.ws = args.ws;
    for (int u = F.tid; u < (LDS_BYTES - LDSCTL_OFF) / 4; u += NWAVES * 64) ((LAS unsigned*)(F.lds + LDSCTL_OFF))[u] = 0u;
    __syncthreads();
#if ONE_LAUNCH
    XcdBarrier bar = xcd_barrier_post((unsigned*)(args.ws + WS_CTL) + CW_BAR, (volatile LAS unsigned*)(F.lds + MISC_OFF) + 8);
#define SEAM() xcd_barrier(bar)
#else
#define SEAM() do {} while (0)
#endif
    const int lo = args.ph_lo, hi = args.ph_hi;
    const int G = gridDim.x, cid = blockIdx.x;
#ifndef SUBMASK
#define SUBMASK 0xFFFF
#endif
#define SUBON(x) ((ONLY_SUB < 0 && ((SUBMASK >> (x)) & 1)) || ONLY_SUB == (x))
    if (lo == 0 && SUBON(10)) { p0_prologue(F); if (hi > 1) SEAM(); }
    for (int ph = (lo > 1 ? lo : 1); ph < (hi < NPHASES - 1 ? hi : NPHASES - 1); ++ph) {
        { int t_ = threadIdx.x; asm volatile("" : "+v"(t_)); F.tid = t_; F.lane = t_ & 63; F.wave = __builtin_amdgcn_readfirstlane(t_ >> 6);
          size_t z_ = 0; asm volatile("" : "+s"(z_));
          F.ws = args.ws + z_; F.out = args.out + z_; }
        unsigned char* ws = F.ws;
        {
            const int l = (ph - 1) / 6, sub = (ph - 1) % 6;
            if (sub == 0 && SUBON(0)) {
                pg8::Gemm g{(const bf16*)(ws + WS_YB), w_ptr(ws, l, W_IN), MPAD, NPROJ, D}; pg8::StaticOrder S; S.init(MPAD, NPROJ, G, cid);
                EpiIn E{stats_ptr(ws, l), gw_ptr(ws, l, 0), gw_ptr(ws, l, 1), (const float*)(ws + WS_SMALL + SM_LB) + l * HGW, (const f32x2*)(ws + WS_SMALL + SM_ROPE),
                        (bf16*)(ws + WS_R + R_QT), (bf16*)(ws + WS_R + R_KT), (bf16*)(ws + WS_R + R_VR), (bf16*)(ws + WS_R + R_GT), (float*)(ws + WS_R + R_DEC), (float*)(ws + WS_R + R_DECS)};
#ifdef DUP_GEMM
                for (int rep_ = 0; rep_ < args.ph_hi - 24; ++rep_) { pg8::gemm_phase<EpiIn, pg8::StaticOrder, true, true>(F.lds, g, S, E); SEAM(); }
#else
                pg8::gemm_phase<EpiIn, pg8::StaticOrder, true, true>(F.lds, g, S, E);
#endif
            } else if (sub == 1 && SUBON(1)) {
#ifdef NAIVE_MIX
                mixer_naive(F, l);
#elif defined(DUP_MIX)
                for (int rep_ = 0; rep_ < args.ph_hi - 24; ++rep_) { mixer_mfma(F, l); SEAM(); }
#else
                mixer_mfma(F, l);
#endif
            } else if (sub == 2 && SUBON(2)) {
                pg8::Gemm g{(const bf16*)(ws + WS_R + R_O), w_ptr(ws, l, W_O), MPAD, D, D}; pg8::StaticOrder S; S.init(MPAD, D, G, cid);
                const float* lg = l ? F.in[I_L2G] + (l - 1) * D : (const float*)(ws + WS_SMALL + SM_ONES);
                const float* lb = l ? F.in[I_L2B] + (l - 1) * D : (const float*)(ws + WS_CTL + 1024);
                EpiRes E{(const float*)(ws + WS_Y), (float*)(ws + WS_Y1), (bf16*)(ws + WS_YB), stats_ptr(ws, l), lg, lb, stats_ptr(ws, 5 + l)};
                pg8::gemm_phase<EpiRes, pg8::StaticOrder, true, true>(F.lds, g, S, E);
            } else if (sub == 3 && SUBON(3)) {
                pg8::Gemm g{(const bf16*)(ws + WS_YB), w_ptr(ws, l, W_AB), MPAD, NAB, D}; pg8::StaticOrder S; S.init(MPAD, NAB, G, cid);
                EpiUp E{stats_ptr(ws, 5 + l), gw_ptr(ws, l, 2), gw_ptr(ws, l, 3), (bf16*)(ws + WS_R + R_A), (bf16*)(ws + WS_R + R_G)};
                pg8::gemm_phase<EpiUp, pg8::StaticOrder, true, true>(F.lds, g, S, E);
            } else if (sub == 4 && SUBON(4)) {
                conv_phase(F, l);
            } else if (SUBON(5)) {
                pg8::Gemm g{(const bf16*)(ws + WS_R + R_G), w_ptr(ws, l, W_DN), MPAD, D, DFF}; pg8::StaticOrder S; S.init(MPAD, D, G, cid);
                EpiRes E{(const float*)(ws + WS_Y1), (float*)(ws + WS_Y), (bf16*)(ws + WS_YB), stats_ptr(ws, 5 + l), F.in[I_L1G] + l * D, F.in[I_L1B] + l * D, stats_ptr(ws, l + 1)};
                pg8::gemm_phase<EpiRes, pg8::StaticOrder, true, true>(F.lds, g, S, E);
            }
        }
        if (ph + 1 < hi) SEAM();
    }
    if (hi == NPHASES && SUBON(11)) {
        { int t_ = threadIdx.x; asm volatile("" : "+v"(t_)); F.tid = t_; F.lane = t_ & 63; F.wave = __builtin_amdgcn_readfirstlane(t_ >> 6); F.ws = args.ws; F.out = args.out; }
        final_phase(F); }
}

extern "C" void kernel_launch(void* const* d_in, const int* in_sizes, int n_in, void* d_out, int out_size, void* d_ws, size_t ws_size, hipStream_t stream) {
    static int grid = 0;
    if (grid == 0) {
        if (n_in != 23 || out_size != (int)O_END || ws_size < WS_END) { fprintf(stderr, "kernel_launch: unexpected shapes: n_in %d out %d ws %zu (need %zu)\n", n_in, out_size, ws_size, (size_t)WS_END); grid = -1; return; }
        int dev = 0, cus = 0;
        if (hipGetDevice(&dev) != hipSuccess || hipDeviceGetAttribute(&cus, hipDeviceAttributeMultiprocessorCount, dev) != hipSuccess) { grid = -1; return; }
        bool ok = true;
#if ONE_LAUNCH
        ok = ok && hipFuncSetAttribute((const void*)hymba_fwd<-1>, hipFuncAttributeMaxDynamicSharedMemorySize, LDS_BYTES) == hipSuccess;
#else
        ok = ok && hipFuncSetAttribute((const void*)hymba_fwd<0>, hipFuncAttributeMaxDynamicSharedMemorySize, LDS_BYTES) == hipSuccess;
        ok = ok && hipFuncSetAttribute((const void*)hymba_fwd<1>, hipFuncAttributeMaxDynamicSharedMemorySize, LDS_BYTES) == hipSuccess;
        ok = ok && hipFuncSetAttribute((const void*)hymba_fwd<2>, hipFuncAttributeMaxDynamicSharedMemorySize, LDS_BYTES) == hipSuccess;
        ok = ok && hipFuncSetAttribute((const void*)hymba_fwd<3>, hipFuncAttributeMaxDynamicSharedMemorySize, LDS_BYTES) == hipSuccess;
        ok = ok && hipFuncSetAttribute((const void*)hymba_fwd<4>, hipFuncAttributeMaxDynamicSharedMemorySize, LDS_BYTES) == hipSuccess;
        ok = ok && hipFuncSetAttribute((const void*)hymba_fwd<5>, hipFuncAttributeMaxDynamicSharedMemorySize, LDS_BYTES) == hipSuccess;
        ok = ok && hipFuncSetAttribute((const void*)hymba_fwd<10>, hipFuncAttributeMaxDynamicSharedMemorySize, LDS_BYTES) == hipSuccess;
        ok = ok && hipFuncSetAttribute((const void*)hymba_fwd<11>, hipFuncAttributeMaxDynamicSharedMemorySize, LDS_BYTES) == hipSuccess;
#endif
        if (!ok) { fprintf(stderr, "kernel_launch: hipFuncSetAttribute failed\n"); grid = -1; return; }
        (void)hipGetLastError();
        grid = cus;
    }
    if (grid < 0) return;
    (void)hipMemsetAsync((char*)d_ws + WS_CTL, 0, CTL_ZERO_BYTES, stream);
    Args a{};
    for (int i = 0; i < 23; ++i) a.in[i] = (const float*)d_in[i];
    a.out = (float*)d_out; a.ws = (unsigned char*)d_ws;
#if ONE_LAUNCH
    a.ph_lo = 0; a.ph_hi = NPHASES;
    hipLaunchKernelGGL(hymba_fwd<-1>, dim3(grid), dim3(NWAVES * 64), LDS_BYTES, stream, a);
#else
    for (int p = 0; p < NPHASES; ++p) { a.ph_lo = p; a.ph_hi = p + 1;
        const int sub = p == 0 ? 10 : p == NPHASES - 1 ? 11 : (p - 1) % 6;
        switch (sub) {
            case 0: hipLaunchKernelGGL(hymba_fwd<0>, dim3(grid), dim3(NWAVES * 64), LDS_BYTES, stream, a); break;
            case 1: hipLaunchKernelGGL(hymba_fwd<1>, dim3(grid), dim3(NWAVES * 64), LDS_BYTES, stream, a); break;
            case 2: hipLaunchKernelGGL(hymba_fwd<2>, dim3(grid), dim3(NWAVES * 64), LDS_BYTES, stream, a); break;
            case 3: hipLaunchKernelGGL(hymba_fwd<3>, dim3(grid), dim3(NWAVES * 64), LDS_BYTES, stream, a); break;
            case 4: hipLaunchKernelGGL(hymba_fwd<4>, dim3(grid), dim3(NWAVES * 64), LDS_BYTES, stream, a); break;
            case 5: hipLaunchKernelGGL(hymba_fwd<5>, dim3(grid), dim3(NWAVES * 64), LDS_BYTES, stream, a); break;
            case 10: hipLaunchKernelGGL(hymba_fwd<10>, dim3(grid), dim3(NWAVES * 64), LDS_BYTES, stream, a); break;
            default: hipLaunchKernelGGL(hymba_fwd<11>, dim3(grid), dim3(NWAVES * 64), LDS_BYTES, stream, a); break;
        }
    }
#endif
}
```

```cpp
#include <hip/hip_runtime.h>
#include <cstdio>
#include <cstdint>
namespace pg8 {
#define PG8_LAS __attribute__((address_space(3)))
typedef unsigned short bf16_t;
typedef short bf16x8 __attribute__((ext_vector_type(8)));
typedef float f32x4 __attribute__((ext_vector_type(4)));
typedef unsigned u32x4 __attribute__((ext_vector_type(4)));
constexpr int BM = 256, BK = 64, HALF = 128, HTB = HALF * BK * 2  , STAGE_BYTES = 8 * HTB, NXCD = 8, WGM = 8;

__host__ __device__ __forceinline__ int lds_byte(int r, int c) { const int st = (r >> 4) * 2 + (c >> 5), rr = r & 15, cc = c & 31, ob = rr * 64 + cc * 2; return st * 1024 + (ob ^ (((ob >> 9) & 1) << 5)); }
__host__ __device__ __forceinline__ void stage_rc(int b, int& R, int& C) { const int st = b / 1024, sb = b % 1024, swz = sb ^ (((sb >> 9) & 1) << 5); R = (st >> 1) * 16 + swz / 64; C = (st & 1) * 32 + (swz % 64) / 2; }
__host__ __device__ __forceinline__ int perm32(int rho) { const int n = rho >> 4, i = rho & 15; return 8 * (i >> 2) + 4 * n + (i & 3); }

struct Unit { int pm, pn; };
struct Gemm { const bf16_t* A; const bf16_t* Bt; int M, N, K; };

struct StaticOrder {
    int nM, nN, nwg, G, c;
    __host__ __device__ void init(int M, int N, int G_, int c_) { nM = M / BM; nN = N / BM; nwg = nM * nN; G = G_; c = c_; }
    __host__ __device__ bool next(int i, Unit& u) const {
        const long L = (long)i * G + c; if (L >= nwg) return false;
        int wgid = (int)L; { const int q = nwg / NXCD, r = nwg % NXCD, xcd = wgid % NXCD, off = wgid / NXCD; wgid = (xcd < r ? xcd * (q + 1) : r * (q + 1) + (xcd - r) * q) + off; }
        const int nig = WGM * nN, gid = wgid / nig, fm = gid * WGM, gsz = (nM - fm) < WGM ? (nM - fm) : WGM;
        u.pm = fm + ((wgid % nig) % gsz); u.pn = (wgid % nig) / gsz; return true;
    }
    __device__ __forceinline__ void a_ready(const Unit&) const {}
    __device__ __forceinline__ void done(const Unit&) const {}
};

__device__ __forceinline__ unsigned cvt_pk_bf16(float lo, float hi) { unsigned r; asm volatile("v_cvt_pk_bf16_f32 %0, %1, %2" : "=v"(r) : "v"(lo), "v"(hi)); return r; }
template <class Epi, class Sched, bool ALIGN_EPI = false, bool SP2 = false>
__device__ __forceinline__ void gemm_phase(PG8_LAS unsigned char* lds, const Gemm g, const Sched& S, const Epi& E) {
    int tid_ = threadIdx.x; asm volatile("" : "+v"(tid_));
    const int tid = tid_, wid = __builtin_amdgcn_readfirstlane(tid >> 6), lane = tid & 63, wr = wid >> 2, wc = wid & 3, fr = lane & 15, fq = lane >> 4;
    const int K = g.K, nt = K / BK;
    unsigned voffA[2], voffB[2];
#pragma unroll
    for (int i = 0; i < 2; ++i) { int R, C; stage_rc(tid * 16 + i * 8192, R, C); const int Rb = Epi::PERM ? ((R & ~31) + perm32(R & 31)) : R;
        voffA[i] = (unsigned)(R * K + C) * 2u; voffB[i] = (unsigned)(Rb * K + C) * 2u; }
    const size_t kstep = (size_t)(BK * 2);
    const size_t hstep = (size_t)HALF * K * 2;
    const size_t tstep = 2 * hstep;
    const unsigned ldsw = (unsigned)wid * 1024u;
    const int aoff = lds_byte(wr * 64 + fr, fq * 8), boff = lds_byte(wc * 32 + fr, fq * 8);
#define PG8_SA(b, h) (((b) * 2 + (h)) * HTB)
#define PG8_SB(b, h) ((4 + (b) * 2 + (h)) * HTB)
#define PG8_STAGE(bufoff, gbase, voff) do { _Pragma("unroll") for (int _i = 0; _i < 2; ++_i) \
        __builtin_amdgcn_global_load_lds((const unsigned*)((const char*)(gbase) + (voff)[_i]), (PG8_LAS unsigned*)(lds + (bufoff) + ldsw + _i * 8192), 16, 0, 0); } while (0)
#define PG8_LDA(dst, b, h) do { _Pragma("unroll") for (int m = 0; m < 4; ++m) _Pragma("unroll") for (int k = 0; k < 2; ++k) dst[m][k] = *(const PG8_LAS bf16x8*)(lds + PG8_SA(b, h) + aoff + m * 2048 + k * 1024); } while (0)
#define PG8_LDB(dst, b, h) do { _Pragma("unroll") for (int n = 0; n < 2; ++n) _Pragma("unroll") for (int k = 0; k < 2; ++k) dst[n][k] = *(const PG8_LAS bf16x8*)(lds + PG8_SB(b, h) + boff + n * 2048 + k * 1024); } while (0)
#define PG8_MMA(ai, bj, At, Bt) do { __builtin_amdgcn_s_setprio(1); _Pragma("unroll") for (int m = 0; m < 4; ++m) _Pragma("unroll") for (int n = 0; n < 2; ++n) _Pragma("unroll") for (int k = 0; k < 2; ++k) \
        acc[ai][bj][m][n] = __builtin_amdgcn_mfma_f32_16x16x32_bf16(Bt[n][k], At[m][k], acc[ai][bj][m][n], 0, 0, 0); __builtin_amdgcn_s_setprio(0); } while (0)
#define PG8_WAIT_V(n) asm volatile("s_waitcnt vmcnt(" #n ")" ::: "memory")
#define PG8_WAIT_L(n) asm volatile("s_waitcnt lgkmcnt(" #n ")" ::: "memory")
#define PG8_BAR __builtin_amdgcn_s_barrier()
#define PG8_SCHED __builtin_amdgcn_sched_barrier(0)
    Unit cur, nxt; int ui = 0;
    if (!S.next(0, cur)) return;
    f32x4 acc[2][2][4][2];
#pragma unroll
    for (int a = 0; a < 2; ++a)
#pragma unroll
        for (int b = 0; b < 2; ++b)
#pragma unroll
            for (int m = 0; m < 4; ++m)
#pragma unroll
                for (int n = 0; n < 2; ++n) acc[a][b][m][n] = (f32x4){0.f, 0.f, 0.f, 0.f};
    bf16x8 At[4][2], B0[2][2], B1[2][2];
    const char* cA = (const char*)g.A + (size_t)cur.pm * tstep; const char* cB = (const char*)g.Bt + (size_t)cur.pn * tstep;
    S.a_ready(cur);
    if constexpr (SP2) {
        PG8_STAGE(PG8_SB(0, 0), cB, voffB); PG8_STAGE(PG8_SB(0, 1), cB + hstep, voffB); PG8_STAGE(PG8_SA(0, 0), cA, voffA); PG8_STAGE(PG8_SA(0, 1), cA + hstep, voffA);
        if (wr == 1) PG8_BAR;
        PG8_WAIT_V(2); PG8_BAR;
        PG8_STAGE(PG8_SB(1, 0), cB + kstep, voffB); PG8_STAGE(PG8_SA(1, 0), cA + kstep, voffA); PG8_STAGE(PG8_SB(1, 1), cB + hstep + kstep, voffB);
        PG8_WAIT_V(6); PG8_BAR;
    } else {
        PG8_STAGE(PG8_SB(0, 0), cB, voffB); PG8_STAGE(PG8_SA(0, 0), cA, voffA); PG8_STAGE(PG8_SB(0, 1), cB + hstep, voffB); PG8_STAGE(PG8_SA(0, 1), cA + hstep, voffA);
        if (wr == 1) PG8_BAR;
        PG8_WAIT_V(4); PG8_BAR;
        PG8_STAGE(PG8_SB(1, 0), cB + kstep, voffB); PG8_STAGE(PG8_SA(1, 0), cA + kstep, voffA); PG8_STAGE(PG8_SB(1, 1), cB + hstep + kstep, voffB);
        PG8_WAIT_V(6); PG8_BAR;
    }
    for (;;) {
        const bool has_next = S.next(ui + 1, nxt);
        const char* nA = has_next ? (const char*)g.A + (size_t)nxt.pm * tstep : cA; const char* nB = has_next ? (const char*)g.Bt + (size_t)nxt.pn * tstep : cB;
        for (int t = 0; t < nt; t += 2) {
            const bool last = (t == nt - 2);
            const char* a1 = cA + (size_t)(t + 1) * kstep;
            const char* a2 = last ? nA : cA + (size_t)(t + 2) * kstep; const char* b2 = last ? nB : cB + (size_t)(t + 2) * kstep;
            const char* a3 = a2 + kstep; const char* b3 = b2 + kstep;
            if (last && has_next) S.a_ready(nxt);
            if constexpr (SP2) {
            PG8_LDB(B0, 0, 0); PG8_LDB(B1, 0, 1); PG8_SCHED; PG8_LDA(At, 0, 0); PG8_STAGE(PG8_SA(1, 1), a1 + hstep, voffA);
            PG8_WAIT_V(8); PG8_WAIT_L(0); PG8_BAR; PG8_MMA(0, 0, At, B0); PG8_MMA(0, 1, At, B1); PG8_BAR; PG8_SCHED;
            PG8_LDA(At, 0, 1); PG8_STAGE(PG8_SB(0, 0), b2, voffB); PG8_STAGE(PG8_SB(0, 1), b2 + hstep, voffB); PG8_STAGE(PG8_SA(0, 0), a2, voffA);
            PG8_WAIT_V(8); PG8_WAIT_L(0); PG8_BAR; PG8_MMA(1, 0, At, B0); PG8_MMA(1, 1, At, B1); PG8_BAR; PG8_SCHED;
            PG8_LDB(B0, 1, 0); PG8_LDB(B1, 1, 1); PG8_SCHED; PG8_LDA(At, 1, 0); PG8_STAGE(PG8_SA(0, 1), a2 + hstep, voffA);
            PG8_WAIT_V(8); PG8_WAIT_L(0); PG8_BAR; PG8_MMA(0, 0, At, B0); PG8_MMA(0, 1, At, B1); PG8_BAR; PG8_SCHED;
            PG8_LDA(At, 1, 1); PG8_STAGE(PG8_SB(1, 0), b3, voffB); PG8_STAGE(PG8_SB(1, 1), b3 + hstep, voffB); PG8_STAGE(PG8_SA(1, 0), a3, voffA);
            PG8_WAIT_V(8); PG8_WAIT_L(0); PG8_BAR; PG8_MMA(1, 0, At, B0); PG8_MMA(1, 1, At, B1); PG8_BAR; PG8_SCHED;
            } else {
            PG8_LDB(B0, 0, 0); PG8_SCHED; PG8_LDA(At, 0, 0); PG8_STAGE(PG8_SA(1, 1), a1 + hstep, voffA);
            PG8_WAIT_L(8); PG8_BAR; PG8_WAIT_L(0); PG8_MMA(0, 0, At, B0); PG8_BAR; PG8_SCHED;
            PG8_LDB(B1, 0, 1); PG8_STAGE(PG8_SB(0, 0), b2, voffB);
            PG8_BAR; PG8_WAIT_L(0); PG8_MMA(0, 1, At, B1); PG8_BAR;
            PG8_LDA(At, 0, 1); PG8_STAGE(PG8_SA(0, 0), a2, voffA);
            PG8_BAR; PG8_WAIT_L(0); PG8_MMA(1, 0, At, B0); PG8_BAR; PG8_SCHED;
            PG8_STAGE(PG8_SB(0, 1), b2 + hstep, voffB);
            PG8_WAIT_V(6); PG8_BAR; PG8_MMA(1, 1, At, B1); PG8_BAR;
            PG8_LDB(B0, 1, 0); PG8_SCHED; PG8_LDA(At, 1, 0); PG8_STAGE(PG8_SA(0, 1), a2 + hstep, voffA);
            PG8_WAIT_L(8); PG8_BAR; PG8_WAIT_L(0); PG8_MMA(0, 0, At, B0); PG8_BAR; PG8_SCHED;
            PG8_LDB(B1, 1, 1); PG8_STAGE(PG8_SB(1, 0), b3, voffB);
            PG8_BAR; PG8_WAIT_L(0); PG8_MMA(0, 1, At, B1); PG8_BAR;
            PG8_LDA(At, 1, 1); PG8_STAGE(PG8_SA(1, 0), a3, voffA);
            PG8_BAR; PG8_WAIT_L(0); PG8_MMA(1, 0, At, B0); PG8_BAR; PG8_SCHED;
            PG8_STAGE(PG8_SB(1, 1), b3 + hstep, voffB);
            PG8_WAIT_V(6); PG8_BAR; PG8_MMA(1, 1, At, B1); PG8_BAR;
            }
        }
        if constexpr (ALIGN_EPI) { if (wr == 0) PG8_BAR; }
        if constexpr (!Epi::AFTER_DRAIN) { E(acc, cur, wr, wc, fr, fq); S.done(cur); }
        if (!has_next) break;
#pragma unroll
        for (int a = 0; a < 2; ++a)
#pragma unroll
            for (int b = 0; b < 2; ++b)
#pragma unroll
                for (int m = 0; m < 4; ++m)
#pragma unroll
                    for (int n = 0; n < 2; ++n) acc[a][b][m][n] = (f32x4){0.f, 0.f, 0.f, 0.f};
        cur = nxt; cA = nA; cB = nB; ++ui;
        if constexpr (ALIGN_EPI) { if (wr == 1) PG8_BAR; }
    }
    PG8_WAIT_V(0);
    if constexpr (!ALIGN_EPI) { if (wr == 0) PG8_BAR; }
    PG8_BAR;
    if constexpr (Epi::AFTER_DRAIN) { E.fused(acc, cur, wr, wc, fr, fq, lds, wid, lane); S.done(cur); }
#undef PG8_SA
#undef PG8_SB
#undef PG8_STAGE
#undef PG8_LDA
#undef PG8_LDB
#undef PG8_MMA
#undef PG8_WAIT_V
#undef PG8_WAIT_L
#undef PG8_BAR
#undef PG8_SCHED
}
}

constexpr int NWAVES = 8;
constexpr int D = 1024, NB = 8, TP = 2064, MP = NB * TP  , NS = 128, TS = 4, MS = NS * TS, MREAL = MP + MS  , MPAD = 17152  ;
constexpr int DEPTH = 4, HGW = 512, NPROJ = 4096, DFF = 2816, NAB = 2 * DFF, SEQP = 2048, NMETA = 16;
constexpr int NPOS = TP + TS;
constexpr float LN_EPS = 1e-5f, F_EPS = 1e-6f;
constexpr float ALPHA = 1.6817928305074290f;
constexpr float RT_KSCALE = 0.08838834764831845f;

constexpr size_t MiB = 1u << 20;
constexpr size_t WS_CTL = 0, CTL_ZERO_BYTES = 2 * MiB;
constexpr size_t CTL_STATS = 256 * 1024;
constexpr size_t CTL_GW = 1536 * 1024;
constexpr int GW_PER_LAYER = 2 * NPROJ + 2 * NAB;
static_assert(CTL_STATS + 9 * (size_t)MPAD * 8 <= CTL_GW && CTL_GW + (size_t)DEPTH * GW_PER_LAYER * 4 <= CTL_ZERO_BYTES, "ctl map");
constexpr size_t WS_SMALL = 2 * MiB;
constexpr size_t SM_LB = 0, SM_ONES = 8192, SM_ROPE = 16384;
static_assert(SM_ROPE + (size_t)NPOS * 64 * 8 <= 2 * MiB, "small map");
constexpr size_t WS_W = 4 * MiB;
constexpr size_t W_LAYER = (size_t)(NPROJ + D + NAB) * D * 2 + (size_t)D * DFF * 2;
constexpr size_t W_IN = 0, W_O = (size_t)NPROJ * D * 2, W_AB = W_O + (size_t)D * D * 2, W_DN = W_AB + (size_t)NAB * D * 2;
constexpr size_t WS_Y = 112 * MiB, WS_Y1 = 179 * MiB, WS_YB = 246 * MiB, WS_R = 280 * MiB;
static_assert(WS_W + DEPTH * W_LAYER <= WS_Y && (size_t)MPAD * D * 4 == 67 * MiB, "weights/y map");
constexpr size_t ACT = (size_t)MPAD * D * 2;
constexpr size_t R_QT = 0, R_KT = ACT, R_VR = 2 * ACT, R_GT = 3 * ACT, R_O = 4 * ACT, R_KTT = 5 * ACT, R_VTT = 6 * ACT, R_DEC = 7 * ACT, R_DECS = R_DEC + (size_t)(MPAD / 16) * HGW * 4;
constexpr size_t R_A = 0, R_G = (size_t)MPAD * DFF * 2;
constexpr size_t WS_END = WS_R + 240 * MiB;
static_assert(R_DECS + (size_t)NS * HGW * 4 <= 240 * MiB && R_G * 2 <= R_O + 0 * ACT + 240 * MiB, "region map");
static_assert(R_G * 2 <= 240 * MiB, "ffn overlay");

constexpr int CW_BAR = 4096;

constexpr int RING_BYTES = 131072, LDSCTL_OFF = RING_BYTES, MISC_OFF = LDSCTL_OFF + 320, LDS_BYTES = 147456;

#define GAS __attribute__((address_space(1)))
#define LAS __attribute__((address_space(3)))
typedef unsigned short bf16;
typedef unsigned v4u __attribute__((ext_vector_type(4)));
typedef unsigned v2u __attribute__((ext_vector_type(2)));
typedef float f32x4 __attribute__((ext_vector_type(4)));
typedef float f32x2 __attribute__((ext_vector_type(2)));
#define LDS_WAIT() asm volatile("s_waitcnt lgkmcnt(0)" ::: "memory")
#define VM_WAIT() asm volatile("s_waitcnt vmcnt(0)" ::: "memory")
__device__ __forceinline__ unsigned f2bf(float f) { unsigned u = __builtin_bit_cast(unsigned, f); return (u + 0x7fffu + ((u >> 16) & 1u)) >> 16; }
__device__ __forceinline__ float bf2f(unsigned h) { return __builtin_bit_cast(float, h << 16); }
__device__ __forceinline__ float bflo(unsigned w) { return __builtin_bit_cast(float, w << 16); }
__device__ __forceinline__ float bfhi(unsigned w) { return __builtin_bit_cast(float, w & 0xffff0000u); }
__device__ __forceinline__ unsigned pk2(float lo, float hi) { return pg8::cvt_pk_bf16(lo, hi); }
__device__ __forceinline__ float sigmoidf_(float x) { return __builtin_amdgcn_rcpf(1.0f + __expf(-x)); }

#define XB_TMO      128
#define XB_XCNT(j)  (256  + 64 * (j))
#define XB_XSUB(j)  (1280 + 64 * (j))
#define XB_XGEN(j)  (2304 + 64 * (j))
#define XB_TOP      3328
#define XB_TOPGEN   3392
#define XCD_BAR_WORDS 3456
#define XB_SPIN_CAP (1u << 18)

__device__ __forceinline__ unsigned xb_ld(unsigned* p)              { return __hip_atomic_load(p, __ATOMIC_RELAXED, __HIP_MEMORY_SCOPE_AGENT); }
__device__ __forceinline__ unsigned xb_add(unsigned* p, unsigned v) { return __hip_atomic_fetch_add(p, v, __ATOMIC_RELAXED, __HIP_MEMORY_SCOPE_AGENT); }
__device__ __forceinline__ unsigned xb_xcc_id() { return (unsigned)__builtin_amdgcn_s_getreg((3 << 11) | 20) & 0xFu; }
#define XB_SPIN(cond, bar) do { unsigned _sp = 0; while (cond) { __builtin_amdgcn_s_sleep(1); \
    if ((++_sp & 255u) == 0u) { if (xb_ld(&(bar)[XB_TMO])) break; if (_sp > XB_SPIN_CAP) { atomicAdd(&(bar)[XB_TMO], 1u); break; } } } } while (0)

struct XcdBarrier {
    unsigned* bar; unsigned x;
    volatile LAS unsigned* st;
};

__device__ __forceinline__ XcdBarrier xcd_barrier_post(unsigned* bar, volatile LAS unsigned* st) {
    XcdBarrier b; b.bar = bar; b.x = xb_xcc_id(); b.st = st;
    if (threadIdx.x == 0) (void)xb_add(&bar[XB_XCNT(b.x)], 1u);
    return b;
}
__device__ __forceinline__ void xcd_barrier_complete(unsigned* bar, unsigned x, unsigned& nloc, unsigned& nx) {
    const unsigned G = gridDim.x * gridDim.y * gridDim.z;
    unsigned sum, cnt, mine, sp = 0u;
    for (;;) {
        sum = 0u; cnt = 0u; mine = 0u;
#pragma unroll
        for (unsigned j = 0; j < 16; ++j) { const unsigned c = xb_ld(&bar[XB_XCNT(j)]); sum += c; cnt += (c > 0u) ? 1u : 0u; mine = (j == x) ? c : mine; }
        if (sum == G) break;
        __builtin_amdgcn_s_sleep(1);
        if ((++sp & 255u) == 0u) { if (xb_ld(&bar[XB_TMO])) break; if (sp > XB_SPIN_CAP) { atomicAdd(&bar[XB_TMO], 1u); break; } }
    }
    nloc = mine > 0u ? mine : 1u; nx = cnt > 0u ? cnt : 1u;
}

__device__ __forceinline__ void xcd_barrier(const XcdBarrier& b) {
    asm volatile("s_waitcnt vmcnt(0)" ::: "memory");
    __syncthreads();
    if (threadIdx.x == 0) {
        unsigned* bar = b.bar;
        __builtin_amdgcn_s_waitcnt(0);
        unsigned nloc = b.st[0], nx = b.st[1];
        if (nloc == 0u) { xcd_barrier_complete(bar, b.x, nloc, nx); b.st[0] = nloc; b.st[1] = nx; }
        const unsigned old = xb_add(&bar[XB_XSUB(b.x)], 1u);
        const unsigned gen = old / nloc;
        if (old + 1u == (gen + 1u) * nloc) {
            __builtin_amdgcn_fence(__ATOMIC_RELEASE, "agent");
            asm volatile("s_waitcnt vmcnt(0)" ::: "memory");
            const unsigned og = xb_add(&bar[XB_TOP], 1u);
            const unsigned tg = og / nx;
            if (og + 1u == (tg + 1u) * nx) xb_add(&bar[XB_TOPGEN], 1u);
            else XB_SPIN(xb_ld(&bar[XB_TOPGEN]) == tg, bar);
            __builtin_amdgcn_fence(__ATOMIC_ACQUIRE, "agent");
            xb_add(&bar[XB_XGEN(b.x)], 1u);
            asm volatile("s_waitcnt vmcnt(0)" ::: "memory");
        } else {
            XB_SPIN(xb_ld(&bar[XB_XGEN(b.x)]) == gen, bar);
            __builtin_amdgcn_fence(__ATOMIC_ACQUIRE, "agent");
            asm volatile("s_waitcnt vmcnt(0)" ::: "memory");
        }
    }
    __syncthreads();
}


struct Frame {
    LAS unsigned char* lds;
    int tid, lane, wave;
    const float* const* in;
    float* out; unsigned char* ws;
};
enum { I_XP = 0, I_XS, I_SHG, I_SRT, I_SCV, I_META, I_EG, I_EB, I_LBL, I_WIN, I_HGN, I_GNG, I_GNB, I_WO, I_L1G, I_L1B, I_WA, I_WB, I_CW, I_CB, I_WD, I_L2G, I_L2B };
constexpr size_t O_YP = 0, O_YS = O_YP + (size_t)NB * SEQP * D, O_HP = O_YS + (size_t)NS * TS * D, O_HS = O_HP + (size_t)DEPTH * NB * 4 * 16384,
                 O_RP = O_HS + (size_t)DEPTH * NS * 4 * 16384, O_RS = O_RP + (size_t)DEPTH * NB * 4 * 16384, O_CP = O_RS + (size_t)DEPTH * NS * 4 * 16384,
                 O_CS = O_CP + (size_t)DEPTH * NB * 2 * DFF, O_END = O_CS + (size_t)DEPTH * NS * 2 * DFF;
static_assert(O_END == 91668480, "output size");

__device__ __forceinline__ f32x2* stats_ptr(unsigned char* ws, int idx) { return (f32x2*)(ws + WS_Y) + (size_t)idx * MPAD * 16; }
__device__ __forceinline__ void load_stats(const f32x2* st, int row, int fq, float& mu, float& rstd) {
    const f32x4* p = (const f32x4*)(st + (size_t)row * 16 + 4 * fq); const f32x4 a = p[0], b = p[1];
    float s1 = (a[0] + a[2]) + (b[0] + b[2]), s2 = (a[1] + a[3]) + (b[1] + b[3]);
    s1 += __shfl_xor(s1, 16); s2 += __shfl_xor(s2, 16); s1 += __shfl_xor(s1, 32); s2 += __shfl_xor(s2, 32);
    mu = s1 * (1.f / D); rstd = __builtin_amdgcn_rsqf(s2 * (1.f / D) - mu * mu + LN_EPS);
}
__device__ __forceinline__ float* gw_ptr(unsigned char* ws, int l, int which) {
    float* p = (float*)(ws + WS_CTL + CTL_GW) + (size_t)l * GW_PER_LAYER;
    return which == 0 ? p : which == 1 ? p + NPROJ : which == 2 ? p + 2 * NPROJ : p + 2 * NPROJ + NAB;
}
constexpr size_t WS_GWP = WS_Y + 32 * MiB;
__device__ __forceinline__ float* gwp_ptr(unsigned char* ws, int l, int kb, int which) {
    float* p = (float*)(ws + WS_GWP) + ((size_t)l * 16 + kb) * GW_PER_LAYER;
    return which == 0 ? p : which == 1 ? p + NPROJ : which == 2 ? p + 2 * NPROJ : p + 2 * NPROJ + NAB;
}
__device__ __forceinline__ bf16* w_ptr(unsigned char* ws, int l, size_t off) { return (bf16*)(ws + WS_W + (size_t)l * W_LAYER + off); }

__device__ __forceinline__ float wave_sum(float v) {
#pragma unroll
    for (int o = 1; o < 64; o <<= 1) v += __shfl_xor(v, o);
    return v;
}

__device__ __forceinline__ float rt_log_gamma(int h) { return h == 0 ? -0.031748698314580298f : h == 1 ? -0.015748356968139168f : h == 2 ? -0.007843177461025892f : -0.003913899321136329f; }
__device__ __forceinline__ int win_src_col(int np) {
    const int tile = np >> 8, j = np & 255, bj = j >> 7, jj = j & 127;
    if (tile < 4) return bj == 0 ? 128 * tile + jj : 512 + 128 * tile + jj;
    if (tile < 6) return 1024 + 256 * (tile - 4) + j;
    if (tile < 8) return 1536 + 256 * (tile - 6) + j;
    if (tile < 12) { const int base = tile < 10 ? 2048 : 2560, hd = 2 * (tile & 1) + (jj >> 6), i = jj & 63; return base + 128 * hd + 64 * bj + i; }
    if (tile < 14) return 3072 + 256 * (tile - 12) + j;
    return 3584 + 256 * (tile - 14) + j;
}
__device__ __forceinline__ float rope_inv(int i) {
    static const float T[64] = {1.0f, 0.865964353f, 0.749894202f, 0.649381638f, 0.562341332f, 0.486967534f, 0.421696514f, 0.365174115f, 0.316227764f, 0.273841977f, 0.237137377f, 0.2053525f, 0.177827939f, 0.153992653f, 0.133352146f, 0.115478195f, 0.100000001f, 0.0865964293f, 0.0749894232f, 0.0649381652f, 0.0562341325f, 0.0486967526f, 0.0421696492f, 0.0365174115f, 0.0316227749f, 0.0273841955f, 0.0237137377f, 0.0205352511f, 0.0177827943f, 0.0153992651f, 0.013335214f, 0.0115478197f, 0.00999999978f, 0.00865964312f, 0.00749894232f, 0.00649381615f, 0.00562341325f, 0.00486967526f, 0.00421696482f, 0.00365174119f, 0.00316227763f, 0.00273841969f, 0.00237137382f, 0.00205352507f, 0.00177827943f, 0.00153992651f, 0.00133352145f, 0.00115478202f, 0.00100000005f, 0.000865964335f, 0.000749894185f, 0.000649381604f, 0.000562341302f, 0.000486967532f, 0.000421696517f, 0.000365174114f, 0.000316227757f, 0.000273841957f, 0.00023713737f, 0.00020535251f, 0.00017782794f, 0.00015399266f, 0.00013335215f, 0.0001154782f};
    return T[i];
}
__device__ __forceinline__ void tr_item(const float* W, int Nsrc, int scol, const float* gv, const float* bv, bf16* WT, int K, int n0, float* gW, float* bW, LAS float* scr, int k0, int lane) {
    float bacc = 0.f;
#pragma unroll 8
    for (int i = 0; i < 32; ++i) { const int kk = 2 * i + (lane >> 5); float w = W[(size_t)(k0 + kk) * Nsrc + scol];
        if (gv) { bacc += w * bv[k0 + kk]; w *= gv[k0 + kk]; }
        scr[kk * 33 + (lane & 31)] = w; }
    LDS_WAIT(); asm volatile("" ::: "memory");
    const int c = lane & 7;
#pragma unroll
    for (int j = 0; j < 4; ++j) { const int n = (lane >> 3) + 8 * j; const LAS float* s = scr + (8 * c) * 33 + n;
        unsigned h[8]; float gs = 0.f;
#pragma unroll
        for (int e = 0; e < 8; ++e) { h[e] = f2bf(s[e * 33]); gs += bf2f(h[e]); }
        v4u o; o.x = h[0] | (h[1] << 16); o.y = h[2] | (h[3] << 16); o.z = h[4] | (h[5] << 16); o.w = h[6] | (h[7] << 16);
        *(v4u*)(WT + (size_t)(n0 + n) * K + k0 + 8 * c) = o;
        if (gv) { gs += __shfl_xor(gs, 1); gs += __shfl_xor(gs, 2); gs += __shfl_xor(gs, 4); if (c == 0) gW[n0 + n] = gs; } }
    if (gv) { bacc += __shfl_xor(bacc, 32); if (lane < 32) bW[n0 + lane] = bacc; }
    LDS_WAIT(); asm volatile("" ::: "memory");
}
__device__ __forceinline__ void p0_prologue(Frame& F) {
    unsigned char* ws = F.ws;
    LAS float* scr = (LAS float*)(F.lds + F.wave * 16384);
    const int gw = blockIdx.x * NWAVES + F.wave, NGW = gridDim.x * NWAVES, lane = F.lane;
    const int gtid = blockIdx.x * (NWAVES * 64) + F.tid, NT = gridDim.x * NWAVES * 64;
    constexpr int I_IN = 16 * 128, I_O = 16 * 32, I_AB = 16 * 176, I_D = 44 * 32, I_L = I_IN + I_O + I_AB + I_D;
    for (int it = gw; it < DEPTH * I_L; it += NGW) {
        const int l = it / I_L; int r = it - l * I_L;
        if (r < I_IN) { const int kb = r / 128, nb = r % 128, n0 = 32 * nb;
            const float* gv = l ? F.in[I_L2G] + (l - 1) * D : nullptr; const float* bv = l ? F.in[I_L2B] + (l - 1) * D : nullptr;
            tr_item(F.in[I_WIN] + (size_t)l * D * NPROJ, NPROJ, win_src_col(n0 + (lane & 31)), gv, bv, w_ptr(ws, l, W_IN), D, n0, gwp_ptr(ws, l, kb, 0), gwp_ptr(ws, l, kb, 1), scr, 64 * kb, lane); continue; }
        r -= I_IN;
        if (r < I_O) { const int kb = r / 32, nb = r % 32, n0 = 32 * nb;
            tr_item(F.in[I_WO] + (size_t)l * D * D, D, n0 + (lane & 31), nullptr, nullptr, w_ptr(ws, l, W_O), D, n0, nullptr, nullptr, scr, 64 * kb, lane); continue; }
        r -= I_O;
        if (r < I_AB) { const int kb = r / 176, nb = r % 176, n0 = 32 * nb, tile = n0 >> 8, bj = (n0 >> 7) & 1, jj = (n0 & 127) + (lane & 31);
            const float* W = (bj ? F.in[I_WB] : F.in[I_WA]) + (size_t)l * D * DFF;
            tr_item(W, DFF, 128 * tile + jj, F.in[I_L1G] + l * D, F.in[I_L1B] + l * D, w_ptr(ws, l, W_AB), D, n0, gwp_ptr(ws, l, kb, 2), gwp_ptr(ws, l, kb, 3), scr, 64 * kb, lane); continue; }
        r -= I_AB;
        { const int kb = r / 32, nb = r % 32, n0 = 32 * nb;
            tr_item(F.in[I_WD] + (size_t)l * DFF * D, D, n0 + (lane & 31), nullptr, nullptr, w_ptr(ws, l, W_DN), DFF, n0, nullptr, nullptr, scr, 64 * kb, lane); }
    }
    float* lb = (float*)(ws + WS_SMALL + SM_LB);
    if (gtid < HGW) { const float* L = F.in[I_LBL]; const float a0 = L[gtid], a1 = L[HGW + gtid], a2 = L[2 * HGW + gtid], a3 = L[3 * HGW + gtid];
        const float mx = fmaxf(fmaxf(a0, a1), fmaxf(a2, a3)); const float e0 = expf(a0 - mx), e1 = expf(a1 - mx), e2 = expf(a2 - mx), e3 = expf(a3 - mx), inv = 1.0f / (e0 + e1 + e2 + e3);
        lb[gtid] = 0.f; lb[HGW + gtid] = e1 * inv; lb[2 * HGW + gtid] = (e1 + e2) * inv; lb[3 * HGW + gtid] = (e1 + e2 + e3) * inv; }
    if (gtid >= 1024 && gtid < 2048) ((float*)(ws + WS_SMALL + SM_ONES))[gtid - 1024] = 1.0f;
    { f32x2* st = stats_ptr(ws, 0); for (int r = gtid; r < MPAD * 16; r += NT) st[r] = (f32x2){0.f, 64.0f * (1.0f - LN_EPS)}; }
    { f32x2* rope = (f32x2*)(ws + WS_SMALL + SM_ROPE);
      for (int e = gtid; e < NPOS * 64; e += NT) { const int pi = e >> 6, i = e & 63; const int pos = pi < TP ? pi : 16384 + (pi - TP);
          const float ang = (float)pos * rope_inv(i);
          double q = (double)ang * 0.15915494309189535; q -= __builtin_rint(q);
          const float fr = (float)q;
          rope[e] = (f32x2){__builtin_amdgcn_cosf(fr), __builtin_amdgcn_sinf(fr)}; } }
    bf16* YB = (bf16*)(ws + WS_YB);
    const float* eg = F.in[I_EG]; const float* eb = F.in[I_EB];
    for (int row = gw; row < MPAD; row += NGW) {
        v2u* bo = (v2u*)(YB + (size_t)row * D) + lane;
        if (row >= MREAL) {
#pragma unroll
            for (int j = 0; j < 4; ++j) bo[64 * j] = (v2u){0u, 0u};
            continue; }
        const float* src;
        if (row < MP) { const int b = row / TP, t = row - b * TP; src = t < NMETA ? F.in[I_META] + (size_t)t * D : F.in[I_XP] + ((size_t)b * SEQP + (t - NMETA)) * D; }
        else src = F.in[I_XS] + (size_t)(row - MP) * D;
        const f32x4* xr = (const f32x4*)src + lane;
        f32x4 v[4]; float s = 0.f;
#pragma unroll
        for (int j = 0; j < 4; ++j) { v[j] = xr[64 * j]; s += (v[j].x + v[j].y) + (v[j].z + v[j].w); }
        const float mean = wave_sum(s) * (1.f / D); float s2 = 0.f;
#pragma unroll
        for (int j = 0; j < 4; ++j) { v[j] = v[j] - mean; s2 += (v[j].x * v[j].x + v[j].y * v[j].y) + (v[j].z * v[j].z + v[j].w * v[j].w); }
        const float rstd = 1.f / sqrtf(wave_sum(s2) * (1.f / D) + LN_EPS);
#pragma unroll
        for (int j = 0; j < 4; ++j) { const f32x4 g = ((const f32x4*)eg)[lane + 64 * j], b = ((const f32x4*)eb)[lane + 64 * j]; const f32x4 y = v[j] * rstd * g + b;
            bo[64 * j] = (v2u){pk2(y.x, y.y), pk2(y.z, y.w)}; }
    }
}

using pg8::Unit;
struct EpiIn {
    static constexpr bool PERM = true, AFTER_DRAIN = false;
    const f32x2* st; const float* gW; const float* bW; const float* lb; const f32x2* rope;
    bf16* QT; bf16* KT; bf16* VR; bf16* GT; float* DEC; float* DECS;
    template <int TYPE>
    __device__ __forceinline__ void run(const f32x4 (&acc)[2][2][4][2], const Unit& u, int wr, int wc, int fr, int fq) const {
        const int pn = u.pn, jj0 = wc * 32 + 8 * fq;
        f32x4 lbv[2] = {(f32x4){0.f, 0.f, 0.f, 0.f}, (f32x4){0.f, 0.f, 0.f, 0.f}};
        if (TYPE == 0) { lbv[0] = *(const f32x4*)(lb + 128 * pn + jj0); lbv[1] = *(const f32x4*)(lb + 128 * pn + jj0 + 4); }
        const int hd = 2 * (pn & 1) + (jj0 >> 6), i0 = jj0 & 63;
        const float lg = rt_log_gamma(hd);
        const int cb12 = ((pn & 8) ? 512 : 0) + 256 * (pn & 1);
#pragma unroll
        for (int ai = 0; ai < 2; ++ai) {
            const int rowbase = u.pm * 256 + ai * 128 + wr * 64;
            const bool smp = rowbase >= MP;
            const int tau = smp ? (fr & 3) : fr;
#pragma unroll
            for (int m = 0; m < 4; ++m) {
                const int row = rowbase + 16 * m + fr;
                float mu, rstd; load_stats(st, row, fq, mu, rstd);
                f32x4 v[2][2];
#pragma unroll
                for (int bj = 0; bj < 2; ++bj)
#pragma unroll
                    for (int n = 0; n < 2; ++n) { const f32x4 gwv = *(const f32x4*)(gW + 256 * pn + 128 * bj + jj0 + 4 * n), bwv = *(const f32x4*)(bW + 256 * pn + 128 * bj + jj0 + 4 * n);
                        v[bj][n] = (acc[ai][bj][m][n] - mu * gwv) * rstd + bwv; }
                if (TYPE == 0) {
                    float qt[8], kt[8], bb[8];
#pragma unroll
                    for (int n = 0; n < 2; ++n)
#pragma unroll
                        for (int i = 0; i < 4; ++i) { const float hq = v[0][n][i], hf = v[1][n][i], l0 = lbv[n][i];
                            const float sg = sigmoidf_(hf), f = l0 + (1.f - l0) * sg; float b = __logf(fmaxf(f, F_EPS));
                            const float kk = (1.f - l0) * (1.f - sg), q = hq * sigmoidf_(hq);
                            { float y = __builtin_bit_cast(float, __builtin_amdgcn_update_dpp(0, __builtin_bit_cast(int, b), 0x111, 0xF, 0xF, true)); b += (tau >= 1) ? y : 0.f;
                              y = __builtin_bit_cast(float, __builtin_amdgcn_update_dpp(0, __builtin_bit_cast(int, b), 0x112, 0xF, 0xF, true)); b += (tau >= 2) ? y : 0.f;
                              if (!smp) { b += __builtin_bit_cast(float, __builtin_amdgcn_update_dpp(0, __builtin_bit_cast(int, b), 0x114, 0xF, 0xF, true));
                                          b += __builtin_bit_cast(float, __builtin_amdgcn_update_dpp(0, __builtin_bit_cast(int, b), 0x118, 0xF, 0xF, true)); } }
                            bb[4 * n + i] = b; qt[4 * n + i] = q * __expf(b); kt[4 * n + i] = kk * __expf(-b); }
                    const size_t o = (size_t)row * D + 128 * pn + jj0;
                    *(v4u*)(QT + o) = (v4u){pk2(qt[0], qt[1]), pk2(qt[2], qt[3]), pk2(qt[4], qt[5]), pk2(qt[6], qt[7])};
                    *(v4u*)(KT + o) = (v4u){pk2(kt[0], kt[1]), pk2(kt[2], kt[3]), pk2(kt[4], kt[5]), pk2(kt[6], kt[7])};
                    if (!smp) { if (fr == 15) { float* d = DEC + (size_t)(row >> 4) * HGW + 128 * pn + jj0; *(f32x4*)d = (f32x4){bb[0], bb[1], bb[2], bb[3]}; *(f32x4*)(d + 4) = (f32x4){bb[4], bb[5], bb[6], bb[7]}; } }
                    else if ((fr & 3) == 3) { float* d = DECS + (size_t)((row - MP) >> 2) * HGW + 128 * pn + jj0; *(f32x4*)d = (f32x4){bb[0], bb[1], bb[2], bb[3]}; *(f32x4*)(d + 4) = (f32x4){bb[4], bb[5], bb[6], bb[7]}; }
                } else if (TYPE == 1 || TYPE == 2) {
                    bf16* dst = (TYPE == 1 ? VR : GT) + (size_t)row * D + cb12 + jj0;
#pragma unroll
                    for (int bj = 0; bj < 2; ++bj) { f32x4 a = v[bj][0], b = v[bj][1];
                        if (TYPE == 2) {
#pragma unroll
                            for (int i = 0; i < 4; ++i) { a[i] = a[i] * sigmoidf_(a[i]); b[i] = b[i] * sigmoidf_(b[i]); } }
                        *(v4u*)(dst + 128 * bj) = (v4u){pk2(a[0], a[1]), pk2(a[2], a[3]), pk2(b[0], b[1]), pk2(b[2], b[3])}; }
                } else {
                    const int pi = smp ? TP + ((row - MP) & 3) : row - TP * (row / TP);
                    const f32x4* cs = (const f32x4*)(rope + (size_t)pi * 64 + i0);
                    const float sc = TYPE == 3 ? __expf((float)(tau + 1) * lg) : RT_KSCALE * __expf(-(float)(tau + 1) * lg);
                    float o1[8], o2[8];
#pragma unroll
                    for (int p = 0; p < 4; ++p) { const f32x4 c2 = cs[p];
#pragma unroll
                        for (int e = 0; e < 2; ++e) { const int j = 2 * p + e; const float c = c2[2 * e], sn = c2[2 * e + 1], x1 = v[0][j >> 2][j & 3], x2 = v[1][j >> 2][j & 3];
                            o1[j] = (x1 * c - x2 * sn) * sc; o2[j] = (x1 * sn + x2 * c) * sc; } }
                    bf16* dst = (TYPE == 3 ? QT : KT) + (size_t)row * D + HGW + 128 * hd + i0;
                    *(v4u*)dst = (v4u){pk2(o1[0], o1[1]), pk2(o1[2], o1[3]), pk2(o1[4], o1[5]), pk2(o1[6], o1[7])};
                    *(v4u*)(dst + 64) = (v4u){pk2(o2[0], o2[1]), pk2(o2[2], o2[3]), pk2(o2[4], o2[5]), pk2(o2[6], o2[7])};
                }
                asm volatile("" ::: "memory");
            }
        }
    }
    __device__ __forceinline__ void operator()(const f32x4 (&acc)[2][2][4][2], const Unit& u, int wr, int wc, int fr, int fq) const {
        const int pn = u.pn;
        if (pn < 4) run<0>(acc, u, wr, wc, fr, fq);
        else if (pn == 4 || pn == 5 || pn == 12 || pn == 13) run<1>(acc, u, wr, wc, fr, fq);
        else if (pn == 6 || pn == 7 || pn >= 14) run<2>(acc, u, wr, wc, fr, fq);
        else if (pn < 10) run<3>(acc, u, wr, wc, fr, fq);
        else run<4>(acc, u, wr, wc, fr, fq);
    }
};
struct EpiRes {
    static constexpr bool PERM = true, AFTER_DRAIN = false;
    bf16* YB; const f32x2* st_in; const float* g; const float* b; f32x2* st_out;
    __device__ __forceinline__ void operator()(const f32x4 (&acc)[2][2][4][2], const Unit& u, int wr, int wc, int fr, int fq) const {
        const int col0 = u.pn * 256 + wc * 32 + 8 * fq;
        f32x4 gv[2][2], bv[2][2];
#pragma unroll
        for (int bj = 0; bj < 2; ++bj)
#pragma unroll
            for (int n = 0; n < 2; ++n) { gv[bj][n] = *(const f32x4*)(g + col0 + 128 * bj + 4 * n); bv[bj][n] = *(const f32x4*)(b + col0 + 128 * bj + 4 * n); }
#pragma unroll
        for (int ai = 0; ai < 2; ++ai)
#pragma unroll
            for (int m = 0; m < 4; ++m) {
                const int row = u.pm * 256 + ai * 128 + wr * 64 + 16 * m + fr;
                float mu, rstd; load_stats(st_in, row, fq, mu, rstd);
                bf16* yp = YB + (size_t)row * D + col0; float sy = 0.f, sq = 0.f;
#pragma unroll
                for (int bj = 0; bj < 2; ++bj) { const v4u yi = *(const v4u*)(yp + 128 * bj);
                    const f32x4 y0 = (f32x4){bflo(yi.x), bfhi(yi.x), bflo(yi.y), bfhi(yi.y)}, y1 = (f32x4){bflo(yi.z), bfhi(yi.z), bflo(yi.w), bfhi(yi.w)};
                    const f32x4 a = ALPHA * ((y0 - mu) * rstd * gv[bj][0] + bv[bj][0]) + acc[ai][bj][m][0], c = ALPHA * ((y1 - mu) * rstd * gv[bj][1] + bv[bj][1]) + acc[ai][bj][m][1];
                    *(v4u*)(yp + 128 * bj) = (v4u){pk2(a[0], a[1]), pk2(a[2], a[3]), pk2(c[0], c[1]), pk2(c[2], c[3])};
                    sy += ((a[0] + a[1]) + (a[2] + a[3])) + ((c[0] + c[1]) + (c[2] + c[3]));
                    sq += ((a[0] * a[0] + a[1] * a[1]) + (a[2] * a[2] + a[3] * a[3])) + ((c[0] * c[0] + c[1] * c[1]) + (c[2] * c[2] + c[3] * c[3])); }
                sy += __shfl_xor(sy, 16); sy += __shfl_xor(sy, 32); sq += __shfl_xor(sq, 16); sq += __shfl_xor(sq, 32);
                if (fq == 0) st_out[(size_t)row * 16 + 4 * u.pn + wc] = (f32x2){sy, sq};
                if (m & 1) asm volatile("" ::: "memory");
            }
    }
};
struct EpiUp {
    static constexpr bool PERM = true, AFTER_DRAIN = false;
    const f32x2* st; const float* gW; const float* bW; bf16* A; bf16* G;
    __device__ __forceinline__ void operator()(const f32x4 (&acc)[2][2][4][2], const Unit& u, int wr, int wc, int fr, int fq) const {
        const int pn = u.pn, jj0 = wc * 32 + 8 * fq;
        f32x4 gw[2][2], bw[2][2];
#pragma unroll
        for (int bj = 0; bj < 2; ++bj)
#pragma unroll
            for (int n = 0; n < 2; ++n) { gw[bj][n] = *(const f32x4*)(gW + 256 * pn + 128 * bj + jj0 + 4 * n); bw[bj][n] = *(const f32x4*)(bW + 256 * pn + 128 * bj + jj0 + 4 * n); }
#pragma unroll
        for (int ai = 0; ai < 2; ++ai)
#pragma unroll
            for (int m = 0; m < 4; ++m) {
                const int row = u.pm * 256 + ai * 128 + wr * 64 + 16 * m + fr;
                float mu, rstd; load_stats(st, row, fq, mu, rstd);
                const size_t o = (size_t)row * DFF + 128 * pn + jj0;
#pragma unroll
                for (int bj = 0; bj < 2; ++bj) { const f32x4 a = (acc[ai][bj][m][0] - mu * gw[bj][0]) * rstd + bw[bj][0], b = (acc[ai][bj][m][1] - mu * gw[bj][1]) * rstd + bw[bj][1];
                    *(v4u*)((bj ? G : A) + o) = (v4u){pk2(a[0], a[1]), pk2(a[2], a[3]), pk2(b[0], b[1]), pk2(b[2], b[3])}; }
            }
    }
};

__device__ __forceinline__ void mixer_naive(Frame& F, int l) {
    unsigned char* ws = F.ws;
    const int tid = F.tid, v = tid & 127, kq = tid >> 7;
    LAS unsigned char* L = F.lds;
    LAS bf16* TL = (LAS bf16*)L;
    LAS float* Es = (LAS float*)(L + 16384);
    LAS float* OP = (LAS float*)(L + 16384 + 512);
    const bf16* QT = (const bf16*)(ws + WS_R + R_QT); const bf16* KT = (const bf16*)(ws + WS_R + R_KT); const bf16* VR = (const bf16*)(ws + WS_R + R_VR); const bf16* GT = (const bf16*)(ws + WS_R + R_GT);
    bf16* O = (bf16*)(ws + WS_R + R_O);
    const float* DEC = (const float*)(ws + WS_R + R_DEC); const float* DECS = (const float*)(ws + WS_R + R_DECS);
    const int w = blockIdx.x;
    for (int it = 0;; ++it) {
        bool smp; int seq, H, nchunks, ntok, row_base;
        if (w < 64) { if (it > 0) break; smp = false; seq = w >> 3; H = w & 7; nchunks = TP / 16; ntok = 16; row_base = seq * TP; }
        else { const int id = (w - 64) + (int)(gridDim.x - 64) * it; if (id >= NS * 8) break; smp = true; seq = id >> 3; H = id & 7; nchunks = 1; ntok = 4; row_base = MP + 4 * seq; }
        const bool hg = H < 4; const int h = H & 3;
        float Z[32];
        if (smp) { const float* S0 = (hg ? F.in[I_SHG] : F.in[I_SRT]) + (((size_t)l * NS + seq) * 4 + h) * 16384;
#pragma unroll
            for (int j = 0; j < 32; ++j) Z[j] = S0[(kq * 32 + j) * 128 + v]; }
        else {
#pragma unroll
            for (int j = 0; j < 32; ++j) Z[j] = 0.f; }
        const float lg = rt_log_gamma(h), Eret = __expf(lg * (float)ntok);
        const float* nrm_g = hg ? F.in[I_HGN] + l * HGW + 128 * h : F.in[I_GNG] + l * HGW + 128 * h;
        const float* nrm_b = F.in[I_GNB] + l * HGW + 128 * h;
        for (int c = 0; c < nchunks; ++c) {
            const int row0 = row_base + 16 * c;
            { const int tile = tid >> 7, p = tid & 127; const bf16* src = tile == 0 ? QT : tile == 1 ? KT : tile == 2 ? VR : GT;
#pragma unroll
              for (int rr = 0; rr < 2; ++rr) { const int r = (p >> 4) + 8 * rr; v4u x = (v4u){0u, 0u, 0u, 0u};
                  if (r < ntok) x = *(const v4u*)(src + (size_t)(row0 + r) * D + 128 * H + (p & 15) * 8);
                  *(LAS v4u*)(TL + tile * 2048 + r * 128 + (p & 15) * 8) = x; } }
            if (tid < 128) Es[tid] = hg ? __expf(smp ? DECS[(size_t)seq * HGW + 128 * h + tid] : DEC[(size_t)(row0 >> 4) * HGW + 128 * h + tid]) : Eret;
            __syncthreads();
            for (int t = 0; t < ntok; ++t) {
                const float vv = bf2f(TL[2 * 2048 + t * 128 + v]);
                float op = 0.f;
#pragma unroll
                for (int j4 = 0; j4 < 4; ++j4) { const v4u kw = *(const LAS v4u*)(TL + 2048 + t * 128 + kq * 32 + 8 * j4), qw = *(const LAS v4u*)(TL + t * 128 + kq * 32 + 8 * j4);
#pragma unroll
                    for (int e = 0; e < 4; ++e) { const unsigned ku = kw[e], qu = qw[e];
                        Z[8 * j4 + 2 * e] = fmaf(bflo(ku), vv, Z[8 * j4 + 2 * e]); op = fmaf(Z[8 * j4 + 2 * e], bflo(qu), op);
                        Z[8 * j4 + 2 * e + 1] = fmaf(bfhi(ku), vv, Z[8 * j4 + 2 * e + 1]); op = fmaf(Z[8 * j4 + 2 * e + 1], bfhi(qu), op); } }
                OP[(t * 4 + kq) * 128 + v] = op;
            }
            __syncthreads();
            { const int tt = tid >> 5, v4 = (tid & 31) * 4;
              f32x4 o = (f32x4){0.f, 0.f, 0.f, 0.f};
              if (tt < ntok) {
#pragma unroll
                  for (int q = 0; q < 4; ++q) o += *(const LAS f32x4*)(OP + (tt * 4 + q) * 128 + v4); }
              float s = (o[0] + o[1]) + (o[2] + o[3]), ss = (o[0] * o[0] + o[1] * o[1]) + (o[2] * o[2] + o[3] * o[3]);
#pragma unroll
              for (int x = 1; x < 32; x <<= 1) { s += __shfl_xor(s, x); ss += __shfl_xor(ss, x); }
              const v2u gwd = *(const LAS v2u*)(TL + 3 * 2048 + tt * 128 + v4);
              const float gt[4] = {bflo(gwd.x), bfhi(gwd.x), bflo(gwd.y), bfhi(gwd.y)};
              const f32x4 ng = *(const f32x4*)(nrm_g + v4);
              float r[4];
              if (hg) { const float rs = __builtin_amdgcn_rsqf(ss * (1.f / 128.f) + LN_EPS);
#pragma unroll
                  for (int i = 0; i < 4; ++i) r[i] = o[i] * rs * ng[i] * gt[i]; }
              else { const f32x4 nb = *(const f32x4*)(nrm_b + v4); const float mean = s * (1.f / 128.f), rs = __builtin_amdgcn_rsqf(ss * (1.f / 128.f) - mean * mean + LN_EPS);
#pragma unroll
                  for (int i = 0; i < 4; ++i) r[i] = ((o[i] - mean) * rs * ng[i] + nb[i]) * gt[i]; }
              if (tt < ntok) *(v2u*)(O + (size_t)(row0 + tt) * D + 128 * H + v4) = (v2u){pk2(r[0], r[1]), pk2(r[2], r[3])}; }
#pragma unroll
            for (int j = 0; j < 32; ++j) Z[j] *= Es[kq * 32 + j];
            __syncthreads();
        }
        float* dst = F.out + (smp ? (hg ? O_HS : O_RS) + (((size_t)l * NS + seq) * 4 + h) * 16384 : (hg ? O_HP : O_RP) + (((size_t)l * NB + seq) * 4 + h) * 16384);
#pragma unroll
        for (int j = 0; j < 32; ++j) dst[(kq * 32 + j) * 128 + v] = Z[j];
    }
}

typedef short bf16x8_t __attribute__((ext_vector_type(8)));
typedef short s16x4_t __attribute__((ext_vector_type(4)));
constexpr int MX_ROWB = 288;
constexpr int MX_ROWR = 264;
constexpr int MX_OP = 132;
constexpr int MX_TQ = 0, MX_TKR = MX_TQ + 64 * MX_ROWR, MX_TK = MX_TKR + 64 * MX_ROWR, MX_TV = MX_TK + 64 * MX_ROWB, MX_ES = MX_TV + 64 * MX_ROWB, MX_TO = MX_ES + 4 * 128 * 4, MX_NG = MX_TO + 64 * MX_OP * 4, MX_END = MX_NG + 2 * 128 * 4;
static_assert(MX_END <= RING_BYTES && MX_TK % 16 == 0 && MX_TO % 16 == 0, "mixer LDS");
__device__ __forceinline__ bf16x8_t mx_ld2(LAS unsigned char* p) { const v2u lo = *(const LAS v2u*)p, hi = *(const LAS v2u*)(p + 32); return __builtin_bit_cast(bf16x8_t, (v4u){lo.x, lo.y, hi.x, hi.y}); }
__device__ __forceinline__ s16x4_t mx_tr4(LAS unsigned char* p) { return __builtin_amdgcn_ds_read_tr16_b64_v4i16((LAS s16x4_t*)p); }
__device__ __forceinline__ bf16x8_t mx_pad(s16x4_t r) { return (bf16x8_t){r[0], r[1], r[2], r[3], 0, 0, 0, 0}; }
__device__ __forceinline__ float dpp_sum8(float x) {
    x += __builtin_bit_cast(float, __builtin_amdgcn_update_dpp(0, __builtin_bit_cast(int, x), 0xB1, 0xF, 0xF, true));
    x += __builtin_bit_cast(float, __builtin_amdgcn_update_dpp(0, __builtin_bit_cast(int, x), 0x4E, 0xF, 0xF, true));
    x += __builtin_bit_cast(float, __builtin_amdgcn_update_dpp(0, __builtin_bit_cast(int, x), 0x141, 0xF, 0xF, true));
    return x;
}
__device__ __forceinline__ void mixer_mfma(Frame& F, int l) {
    unsigned char* ws = F.ws;
    const int tid = F.tid, lane = F.lane, wave = F.wave, l15 = lane & 15, g = lane >> 4, v0 = 16 * wave;
    LAS unsigned char* L = F.lds;
    const bf16* QT = (const bf16*)(ws + WS_R + R_QT); const bf16* KT = (const bf16*)(ws + WS_R + R_KT); const bf16* VR = (const bf16*)(ws + WS_R + R_VR); const bf16* GT = (const bf16*)(ws + WS_R + R_GT);
    bf16* O = (bf16*)(ws + WS_R + R_O);
    const float* DEC = (const float*)(ws + WS_R + R_DEC); const float* DECS = (const float*)(ws + WS_R + R_DECS);
    const int w = blockIdx.x;
    const int qrow_off = l15 * MX_ROWR + 8 * g;
    const int tr_off = (4 * g + (l15 >> 2)) * MX_ROWB + 8 * (l15 & 3);
    const int ftok = tid >> 3, fsg = tid & 7;
    for (int it = 0;; ++it) {
        bool smp; int seq, H, nchunks, ntok, row_base;
        if (w < 64) { if (it > 0) break; smp = false; seq = w >> 3; H = w & 7; nchunks = TP / 16; ntok = 16; row_base = seq * TP; }
        else { const int id = (w - 64) + (int)(gridDim.x - 64) * it; if (id >= NS * 8) break; smp = true; seq = id >> 3; H = id & 7; nchunks = 1; ntok = 4; row_base = MP + 4 * seq; }
        const bool hg = H < 4; const int h = H & 3;
        const int nst = (nchunks + 3) >> 2;
        f32x4 Z[8];
        if (smp) { const float* S0 = (hg ? F.in[I_SHG] : F.in[I_SRT]) + (((size_t)l * NS + seq) * 4 + h) * 16384 + v0 + l15 + 4 * g * 128;
#pragma unroll
            for (int kb = 0; kb < 8; ++kb) { unsigned zo = 16 * 128 * kb; asm volatile("" : "+v"(zo));
#pragma unroll
                for (int r = 0; r < 4; ++r) Z[kb][r] = S0[zo + r * 128]; } }
        else {
#pragma unroll
            for (int kb = 0; kb < 8; ++kb) Z[kb] = (f32x4){0.f, 0.f, 0.f, 0.f}; }
        const float lg = rt_log_gamma(h), Eret = __expf(lg * (float)ntok);
        v4u RQ[2], RK[2], RV[2], RGa, RGb; float RE = 0.f;
#define MX_LOADS(s_) do { const int rb_ = row_base + 64 * (s_); \
            _Pragma("unroll") for (int j_ = 0; j_ < 2; ++j_) { const int id_ = tid + 512 * j_, rr_ = id_ >> 4, cc_ = id_ & 15; \
                if ((rr_ & 15) < ntok && (rr_ >> 4) < nchunks - 4 * (s_)) { const size_t o_ = (size_t)(rb_ + rr_) * D + 128 * H + 8 * cc_; \
                    RQ[j_] = *(const v4u*)(QT + o_); RK[j_] = *(const v4u*)(KT + o_); RV[j_] = *(const v4u*)(VR + o_); } \
                else { RQ[j_] = (v4u){0u, 0u, 0u, 0u}; RK[j_] = RQ[j_]; RV[j_] = RQ[j_]; } } \
            if (hg) { const int c_ = tid >> 7, k_ = tid & 127; RE = smp ? DECS[(size_t)seq * HGW + 128 * h + k_] : ((4 * (s_) + c_) < nchunks ? DEC[(size_t)((row_base >> 4) + 4 * (s_) + c_) * HGW + 128 * h + k_] : 0.f); } } while (0)
#define MX_WRITE(s_) do { \
            _Pragma("unroll") for (int j_ = 0; j_ < 2; ++j_) { const int id_ = tid + 512 * j_, rr_ = id_ >> 4, cc_ = id_ & 15; const int o_ = rr_ * MX_ROWB + 16 * cc_, or_ = rr_ * MX_ROWR + 16 * cc_; \
                *(LAS v2u*)(L + MX_TQ + or_) = (v2u){RQ[j_].x, RQ[j_].y}; *(LAS v2u*)(L + MX_TQ + or_ + 8) = (v2u){RQ[j_].z, RQ[j_].w}; \
                *(LAS v2u*)(L + MX_TKR + or_) = (v2u){RK[j_].x, RK[j_].y}; *(LAS v2u*)(L + MX_TKR + or_ + 8) = (v2u){RK[j_].z, RK[j_].w}; \
                *(LAS v4u*)(L + MX_TK + o_) = RK[j_]; *(LAS v4u*)(L + MX_TV + o_) = RV[j_]; } \
            ((LAS float*)(L + MX_ES))[tid] = hg ? __expf(RE) : Eret; } while (0)
        MX_LOADS(0);
        __syncthreads();
        MX_WRITE(0);
        if (tid < 128) { ((LAS float*)(L + MX_NG))[tid] = (hg ? F.in[I_HGN] : F.in[I_GNG])[l * HGW + 128 * h + tid]; ((LAS float*)(L + MX_NG))[128 + tid] = hg ? 0.f : F.in[I_GNB][l * HGW + 128 * h + tid]; }
        __syncthreads();
        for (int s = 0; s < nst; ++s) {
            const int nch = (nchunks - 4 * s) < 4 ? (nchunks - 4 * s) : 4;
            const bool fvalid = (ftok >> 4) < nch && (ftok & 15) < ntok;
            if (s + 1 < nst) MX_LOADS(s + 1);
#pragma unroll 1
            for (int c = 0; c < nch; ++c) {
                LAS unsigned char* tq = L + MX_TQ + c * 16 * MX_ROWR; LAS unsigned char* tkr = L + MX_TKR + c * 16 * MX_ROWR; LAS unsigned char* tk = L + MX_TK + c * 16 * MX_ROWB; LAS unsigned char* tv = L + MX_TV + c * 16 * MX_ROWB;
                bf16x8_t QA[4], KR[4]; s16x4_t KTr[8]; f32x4 EE[8];
#pragma unroll
                for (int ks = 0; ks < 4; ++ks) { QA[ks] = mx_ld2(tq + qrow_off + 64 * ks); KR[ks] = mx_ld2(tkr + qrow_off + 64 * ks); }
                const s16x4_t vt = mx_tr4(tv + tr_off + 2 * v0);
#pragma unroll
                for (int kb = 0; kb < 8; ++kb) KTr[kb] = mx_tr4(tk + tr_off + 32 * kb);
#pragma unroll
                for (int kb = 0; kb < 8; ++kb) EE[kb] = *(const LAS f32x4*)(L + MX_ES + (c * 128 + 16 * kb + 4 * g) * 4);
                __builtin_amdgcn_sched_barrier(0);
                f32x4 pt = (f32x4){0.f, 0.f, 0.f, 0.f};
#pragma unroll
                for (int ks = 0; ks < 4; ++ks) pt = __builtin_amdgcn_mfma_f32_16x16x32_bf16(KR[ks], QA[ks], pt, 0, 0, 0);
#pragma unroll
                for (int r = 0; r < 4; ++r) pt[r] = (4 * g + r <= l15) ? pt[r] : 0.f;
                const bf16x8_t PA = __builtin_bit_cast(bf16x8_t, (v4u){pk2(pt[0], pt[1]), pk2(pt[2], pt[3]), 0u, 0u});
                const bf16x8_t VB = mx_pad(vt);
                f32x4 o = __builtin_amdgcn_mfma_f32_16x16x32_bf16(PA, VB, (f32x4){0.f, 0.f, 0.f, 0.f}, 0, 0, 0);
#pragma unroll
                for (int ks = 0; ks < 4; ++ks) { const bf16x8_t ZB = __builtin_bit_cast(bf16x8_t, (v4u){pk2(Z[2 * ks][0], Z[2 * ks][1]), pk2(Z[2 * ks][2], Z[2 * ks][3]), pk2(Z[2 * ks + 1][0], Z[2 * ks + 1][1]), pk2(Z[2 * ks + 1][2], Z[2 * ks + 1][3])});
                    o = __builtin_amdgcn_mfma_f32_16x16x32_bf16(QA[ks], ZB, o, 0, 0, 0); }
#pragma unroll
                for (int kb = 0; kb < 8; ++kb) Z[kb] = __builtin_amdgcn_mfma_f32_16x16x32_bf16(mx_pad(KTr[kb]), VB, Z[kb], 0, 0, 0);
#pragma unroll
                for (int kb = 0; kb < 8; ++kb) Z[kb] *= EE[kb];
                LAS float* to = (LAS float*)(L + MX_TO) + (c * 16 + 4 * g) * MX_OP + v0 + l15;
#pragma unroll
                for (int r = 0; r < 4; ++r) to[r * MX_OP] = o[r];
            }
            __syncthreads();
            { const size_t o_ = (size_t)(row_base + 64 * s + (fvalid ? ftok : 0)) * D + 128 * H + 16 * fsg; RGa = *(const v4u*)(GT + o_); RGb = *(const v4u*)(GT + o_ + 8); }
            if (s + 1 < nst) MX_WRITE(s + 1);
            {
                const LAS f32x4* op = (const LAS f32x4*)((LAS float*)(L + MX_TO) + ftok * MX_OP + 16 * fsg);
                f32x4 ov[4]; float s1 = 0.f, s2 = 0.f;
#pragma unroll
                for (int q = 0; q < 4; ++q) { ov[q] = op[q]; s1 += (ov[q][0] + ov[q][1]) + (ov[q][2] + ov[q][3]); s2 += (ov[q][0] * ov[q][0] + ov[q][1] * ov[q][1]) + (ov[q][2] * ov[q][2] + ov[q][3] * ov[q][3]); }
                s1 = dpp_sum8(s1); s2 = dpp_sum8(s2);
                const float mean = hg ? 0.f : s1 * (1.f / 128.f); const float rs = __builtin_amdgcn_rsqf(s2 * (1.f / 128.f) - mean * mean + LN_EPS);
                const unsigned gw_[8] = {RGa.x, RGa.y, RGa.z, RGa.w, RGb.x, RGb.y, RGb.z, RGb.w};
                unsigned ow[8];
#pragma unroll
                for (int q = 0; q < 4; ++q) { const f32x4 ngv = *(const LAS f32x4*)(L + MX_NG + (16 * fsg + 4 * q) * 4), nbv = *(const LAS f32x4*)(L + MX_NG + (128 + 16 * fsg + 4 * q) * 4);
                    const f32x4 y = ((ov[q] - mean) * rs * ngv + nbv);
                    ow[2 * q] = pk2(y[0] * bflo(gw_[2 * q]), y[1] * bfhi(gw_[2 * q])); ow[2 * q + 1] = pk2(y[2] * bflo(gw_[2 * q + 1]), y[3] * bfhi(gw_[2 * q + 1])); }
                if (fvalid) { bf16* dst = O + (size_t)(row_base + 64 * s + ftok) * D + 128 * H + 16 * fsg;
                    *(v4u*)dst = (v4u){ow[0], ow[1], ow[2], ow[3]}; *(v4u*)(dst + 8) = (v4u){ow[4], ow[5], ow[6], ow[7]}; }
            }
            __syncthreads();
        }
        float* dst = F.out + (smp ? (hg ? O_HS : O_RS) + (((size_t)l * NS + seq) * 4 + h) * 16384 : (hg ? O_HP : O_RP) + (((size_t)l * NB + seq) * 4 + h) * 16384) + v0 + l15 + 4 * g * 128;
#pragma unroll
        for (int kb = 0; kb < 8; ++kb) { unsigned zo = 16 * 128 * kb; asm volatile("" : "+v"(zo));
#pragma unroll
            for (int r = 0; r < 4; ++r) dst[zo + r * 128] = Z[kb][r]; }
#undef MX_LOADS
#undef MX_WRITE
    }
}

__device__ __forceinline__ void unpack8(const v4u w, float (&f)[8]) {
#pragma unroll
    for (int e = 0; e < 4; ++e) { f[2 * e] = bflo(w[e]); f[2 * e + 1] = bfhi(w[e]); }
}
__device__ __forceinline__ float gelu_tanh(float x) { const float u = 0.7978845608028654f * (x + 0.044715f * x * x * x); return x * __builtin_amdgcn_rcpf(1.0f + __expf(-2.0f * u)); }
__device__ __forceinline__ void conv_phase(Frame& F, int l) {
    unsigned char* ws = F.ws;
    const bf16* A = (const bf16*)(ws + WS_R + R_A); bf16* G = (bf16*)(ws + WS_R + R_G);
    const float* cw = F.in[I_CW] + (size_t)l * 3 * DFF; const float* cb = F.in[I_CB] + (size_t)l * DFF;
    const float* scv = F.in[I_SCV] + (size_t)l * NS * 2 * DFF;
    float* ocp = F.out + O_CP + (size_t)l * NB * 2 * DFF; float* ocs = F.out + O_CS + (size_t)l * NS * 2 * DFF;
    constexpr int FG = DFF / 8  , NRC = MPAD / 16  ;
    const int gtid = blockIdx.x * (NWAVES * 64) + F.tid, NT = gridDim.x * NWAVES * 64;
    for (int item = gtid; item < NRC * FG; item += NT) {
        const int rc = item / FG, fg = item - rc * FG, f0 = fg * 8, row0 = rc * 16;
        if (row0 >= MREAL) { for (int r = 0; r < 16; ++r) *(v4u*)(G + (size_t)(row0 + r) * DFF + f0) = (v4u){0u, 0u, 0u, 0u}; continue; }
        float w0[8], w1[8], w2[8], bb[8];
#pragma unroll
        for (int e = 0; e < 8; ++e) { w0[e] = cw[f0 + e]; w1[e] = cw[DFF + f0 + e]; w2[e] = cw[2 * DFF + f0 + e]; bb[e] = cb[f0 + e]; }
        const bool smp = row0 >= MP;
        float a1[8], a2[8];
        const int tseq = smp ? 0 : row0 - TP * (row0 / TP);
        if (!smp && tseq > 0) { unpack8(*(const v4u*)(A + (size_t)(row0 - 1) * DFF + f0), a1); unpack8(*(const v4u*)(A + (size_t)(row0 - 2) * DFF + f0), a2); }
        else {
#pragma unroll
            for (int e = 0; e < 8; ++e) { a1[e] = 0.f; a2[e] = 0.f; } }
        for (int r = 0; r < 16; ++r) {
            const int row = row0 + r;
            if (smp && (r & 3) == 0) { const int s = (row - MP) >> 2;
#pragma unroll
                for (int e = 0; e < 8; ++e) { a2[e] = scv[((size_t)s * 2 + 0) * DFF + f0 + e]; a1[e] = scv[((size_t)s * 2 + 1) * DFF + f0 + e]; } }
            float a0[8], g[8], hh[8];
            unpack8(*(const v4u*)(A + (size_t)row * DFF + f0), a0); unpack8(*(const v4u*)(G + (size_t)row * DFF + f0), g);
#pragma unroll
            for (int e = 0; e < 8; ++e) { const float cv = bb[e] + w0[e] * a2[e] + w1[e] * a1[e] + w2[e] * a0[e]; hh[e] = gelu_tanh(cv) * g[e]; }
            *(v4u*)(G + (size_t)row * DFF + f0) = (v4u){pk2(hh[0], hh[1]), pk2(hh[2], hh[3]), pk2(hh[4], hh[5]), pk2(hh[6], hh[7])};
            if (!smp) { const int t = tseq + r; if (t >= TP - 2) { float* d = ocp + ((size_t)(row0 / TP) * 2 + (t - (TP - 2))) * DFF + f0;
#pragma unroll
                    for (int e = 0; e < 8; ++e) d[e] = a0[e]; } }
            else if ((r & 3) >= 2) { float* d = ocs + ((size_t)((row - MP) >> 2) * 2 + ((r & 3) - 2)) * DFF + f0;
#pragma unroll
                for (int e = 0; e < 8; ++e) d[e] = a0[e]; }
#pragma unroll
            for (int e = 0; e < 8; ++e) { a2[e] = a1[e]; a1[e] = a0[e]; }
        }
    }
}

__device__ __forceinline__ void final_phase(Frame& F) {
    unsigned char* ws = F.ws;
    const bf16* YB = (const bf16*)(ws + WS_YB); const f32x2* st = stats_ptr(ws, 4);
    const float* g = F.in[I_L2G] + 3 * D; const float* b = F.in[I_L2B] + 3 * D;
    const int gw = blockIdx.x * NWAVES + F.wave, NGW = gridDim.x * NWAVES, lane = F.lane;
    for (int row = gw; row < MREAL; row += NGW) {
        float* dst;
        if (row < MP) { const int bb = row / TP, t = row - bb * TP; if (t < NMETA) continue; dst = F.out + O_YP + ((size_t)bb * SEQP + (t - NMETA)) * D; }
        else dst = F.out + O_YS + (size_t)(row - MP) * D;
        const f32x2 sp = st[(size_t)row * 16 + (lane & 15)]; float s1 = sp.x, s2 = sp.y;
#pragma unroll
        for (int o = 1; o < 16; o <<= 1) { s1 += __shfl_xor(s1, o); s2 += __shfl_xor(s2, o); }
        const float mu = s1 * (1.f / D), rstd = __builtin_amdgcn_rsqf(s2 * (1.f / D) - mu * mu + LN_EPS);
#pragma unroll
        for (int j = 0; j < 4; ++j) { const v2u yw = ((const v2u*)(YB + (size_t)row * D))[lane + 64 * j]; const f32x4 y = (f32x4){bflo(yw.x), bfhi(yw.x), bflo(yw.y), bfhi(yw.y)}; const f32x4 gg = ((const f32x4*)g)[lane + 64 * j], bb = ((const f32x4*)b)[lane + 64 * j];
            ((f32x4*)dst)[lane + 64 * j] = (y - mu) * rstd * gg + bb; }
    }
}

#ifndef ONE_LAUNCH
#define ONE_LAUNCH 1
#endif
constexpr int NPHASES = 2 + 6 * DEPTH;
struct Args { const float* in[23]; float* out; unsigned char* ws; int ph_lo, ph_hi; };
template <int ONLY_SUB> __global__ void __launch_bounds__(NWAVES * 64, 2) hymba_fwd(Args args) {
    extern __shared__ __attribute__((aligned(16))) unsigned char lds[];
    Frame F;
    F.lds = (LAS unsigned char*)lds;
    F.tid = threadIdx.x; F.lane = F.tid & 63; F.wave = __builtin_amdgcn_readfirstlane(F.tid >> 6);
    F.in = args.in; F.out = args.out; F.ws = args.ws;
    for (int u = F.tid; u < (LDS_BYTES - LDSCTL_OFF) / 4; u += NWAVES * 64) ((LAS unsigned*)(F.lds + LDSCTL_OFF))[u] = 0u;
    __syncthreads();
#if ONE_LAUNCH
    XcdBarrier bar = xcd_barrier_post((unsigned*)(args.ws + WS_CTL) + CW_BAR, (volatile LAS unsigned*)(F.lds + MISC_OFF) + 8);
#define SEAM() xcd_barrier(bar)
#else
#define SEAM() do {} while (0)
#endif
    const int lo = args.ph_lo, hi = args.ph_hi;
    const int G = gridDim.x, cid = blockIdx.x;
#ifndef SUBMASK
#define SUBMASK 0xFFFF
#endif
#define SUBON(x) ((ONLY_SUB < 0 && ((SUBMASK >> (x)) & 1)) || ONLY_SUB == (x))
    if (lo == 0 && SUBON(10)) { p0_prologue(F); if (hi > 1) SEAM(); }
    for (int ph = (lo > 1 ? lo : 1); ph < (hi < NPHASES - 1 ? hi : NPHASES - 1); ++ph) {
        { int t_ = threadIdx.x; asm volatile("" : "+v"(t_)); F.tid = t_; F.lane = t_ & 63; F.wave = __builtin_amdgcn_readfirstlane(t_ >> 6);
          size_t z_ = 0; asm volatile("" : "+s"(z_));
          F.ws = args.ws + z_; F.out = args.out + z_; }
        unsigned char* ws = F.ws;
        {
            const int l = (ph - 1) / 6, sub = (ph - 1) % 6;
            if (sub == 0 && SUBON(0)) {
                if (l == 0) {
                    const int gtid_ = blockIdx.x * (NWAVES * 64) + F.tid;
                    for (int e = gtid_; e < DEPTH * GW_PER_LAYER; e += (int)gridDim.x * NWAVES * 64) { const int ll = e / GW_PER_LAYER, cc = e - ll * GW_PER_LAYER; float a = 0.f;
                        if (ll > 0 || cc >= 2 * NPROJ) {
#pragma unroll
                            for (int kb = 0; kb < 16; ++kb) a += ((const float*)(ws + WS_GWP))[((size_t)ll * 16 + kb) * GW_PER_LAYER + cc]; }
                        ((float*)(ws + WS_CTL + CTL_GW))[e] = a; } }
                pg8::Gemm g{(const bf16*)(ws + WS_YB), w_ptr(ws, l, W_IN), MPAD, NPROJ, D}; pg8::StaticOrder S; S.init(MPAD, NPROJ, G, cid);
                EpiIn E{stats_ptr(ws, l), gw_ptr(ws, l, 0), gw_ptr(ws, l, 1), (const float*)(ws + WS_SMALL + SM_LB) + l * HGW, (const f32x2*)(ws + WS_SMALL + SM_ROPE),
                        (bf16*)(ws + WS_R + R_QT), (bf16*)(ws + WS_R + R_KT), (bf16*)(ws + WS_R + R_VR), (bf16*)(ws + WS_R + R_GT), (float*)(ws + WS_R + R_DEC), (float*)(ws + WS_R + R_DECS)};
#ifdef DUP_GEMM
                for (int rep_ = 0; rep_ < args.ph_hi - 24; ++rep_) { pg8::gemm_phase<EpiIn, pg8::StaticOrder, true, true>(F.lds, g, S, E); SEAM(); }
#else
                pg8::gemm_phase<EpiIn, pg8::StaticOrder, true, true>(F.lds, g, S, E);
#endif
            } else if (sub == 1 && SUBON(1)) {
#ifdef NAIVE_MIX
                mixer_naive(F, l);
#elif defined(DUP_MIX)
                for (int rep_ = 0; rep_ < args.ph_hi - 24; ++rep_) { mixer_mfma(F, l); SEAM(); }
#else
                mixer_mfma(F, l);
#endif
            } else if (sub == 2 && SUBON(2)) {
                pg8::Gemm g{(const bf16*)(ws + WS_R + R_O), w_ptr(ws, l, W_O), MPAD, D, D}; pg8::StaticOrder S; S.init(MPAD, D, G, cid);
                const float* lg = l ? F.in[I_L2G] + (l - 1) * D : (const float*)(ws + WS_SMALL + SM_ONES);
                const float* lb = l ? F.in[I_L2B] + (l - 1) * D : (const float*)(ws + WS_CTL + 1024);
                EpiRes E{(bf16*)(ws + WS_YB), stats_ptr(ws, l), lg, lb, stats_ptr(ws, 5 + l)};
                pg8::gemm_phase<EpiRes, pg8::StaticOrder, true, true>(F.lds, g, S, E);
            } else if (sub == 3 && SUBON(3)) {
                pg8::Gemm g{(const bf16*)(ws + WS_YB), w_ptr(ws, l, W_AB), MPAD, NAB, D}; pg8::StaticOrder S; S.init(MPAD, NAB, G, cid);
                EpiUp E{stats_ptr(ws, 5 + l), gw_ptr(ws, l, 2), gw_ptr(ws, l, 3), (bf16*)(ws + WS_R + R_A), (bf16*)(ws + WS_R + R_G)};
                pg8::gemm_phase<EpiUp, pg8::StaticOrder, true, true>(F.lds, g, S, E);
            } else if (sub == 4 && SUBON(4)) {
                conv_phase(F, l);
            } else if (SUBON(5)) {
                pg8::Gemm g{(const bf16*)(ws + WS_R + R_G), w_ptr(ws, l, W_DN), MPAD, D, DFF}; pg8::StaticOrder S; S.init(MPAD, D, G, cid);
                EpiRes E{(bf16*)(ws + WS_YB), stats_ptr(ws, 5 + l), F.in[I_L1G] + l * D, F.in[I_L1B] + l * D, stats_ptr(ws, l + 1)};
                pg8::gemm_phase<EpiRes, pg8::StaticOrder, true, true>(F.lds, g, S, E);
            }
        }
        if (ph + 1 < hi) SEAM();
    }
    if (hi == NPHASES && SUBON(11)) {
        { int t_ = threadIdx.x; asm volatile("" : "+v"(t_)); F.tid = t_; F.lane = t_ & 63; F.wave = __builtin_amdgcn_readfirstlane(t_ >> 6); F.ws = args.ws; F.out = args.out; }
        final_phase(F); }
}

extern "C" void kernel_launch(void* const* d_in, const int* in_sizes, int n_in, void* d_out, int out_size, void* d_ws, size_t ws_size, hipStream_t stream) {
    static int grid = 0;
    if (grid == 0) {
        if (n_in != 23 || out_size != (int)O_END || ws_size < WS_END) { fprintf(stderr, "kernel_launch: unexpected shapes: n_in %d out %d ws %zu (need %zu)\n", n_in, out_size, ws_size, (size_t)WS_END); grid = -1; return; }
        int dev = 0, cus = 0;
        if (hipGetDevice(&dev) != hipSuccess || hipDeviceGetAttribute(&cus, hipDeviceAttributeMultiprocessorCount, dev) != hipSuccess) { grid = -1; return; }
        bool ok = true;
#if ONE_LAUNCH
        ok = ok && hipFuncSetAttribute((const void*)hymba_fwd<-1>, hipFuncAttributeMaxDynamicSharedMemorySize, LDS_BYTES) == hipSuccess;
#else
        ok = ok && hipFuncSetAttribute((const void*)hymba_fwd<0>, hipFuncAttributeMaxDynamicSharedMemorySize, LDS_BYTES) == hipSuccess;
        ok = ok && hipFuncSetAttribute((const void*)hymba_fwd<1>, hipFuncAttributeMaxDynamicSharedMemorySize, LDS_BYTES) == hipSuccess;
        ok = ok && hipFuncSetAttribute((const void*)hymba_fwd<2>, hipFuncAttributeMaxDynamicSharedMemorySize, LDS_BYTES) == hipSuccess;
        ok = ok && hipFuncSetAttribute((const void*)hymba_fwd<3>, hipFuncAttributeMaxDynamicSharedMemorySize, LDS_BYTES) == hipSuccess;
        ok = ok && hipFuncSetAttribute((const void*)hymba_fwd<4>, hipFuncAttributeMaxDynamicSharedMemorySize, LDS_BYTES) == hipSuccess;
        ok = ok && hipFuncSetAttribute((const void*)hymba_fwd<5>, hipFuncAttributeMaxDynamicSharedMemorySize, LDS_BYTES) == hipSuccess;
        ok = ok && hipFuncSetAttribute((const void*)hymba_fwd<10>, hipFuncAttributeMaxDynamicSharedMemorySize, LDS_BYTES) == hipSuccess;
        ok = ok && hipFuncSetAttribute((const void*)hymba_fwd<11>, hipFuncAttributeMaxDynamicSharedMemorySize, LDS_BYTES) == hipSuccess;
#endif
        if (!ok) { fprintf(stderr, "kernel_launch: hipFuncSetAttribute failed\n"); grid = -1; return; }
        (void)hipGetLastError();
        grid = cus;
    }
    if (grid < 0) return;
    (void)hipMemsetAsync((char*)d_ws + WS_CTL, 0, CTL_ZERO_BYTES, stream);
    Args a{};
    for (int i = 0; i < 23; ++i) a.in[i] = (const float*)d_in[i];
    a.out = (float*)d_out; a.ws = (unsigned char*)d_ws;
#if ONE_LAUNCH
    a.ph_lo = 0; a.ph_hi = NPHASES;
    hipLaunchKernelGGL(hymba_fwd<-1>, dim3(grid), dim3(NWAVES * 64), LDS_BYTES, stream, a);
#else
    for (int p = 0; p < NPHASES; ++p) { a.ph_lo = p; a.ph_hi = p + 1;
        const int sub = p == 0 ? 10 : p == NPHASES - 1 ? 11 : (p - 1) % 6;
        switch (sub) {
            case 0: hipLaunchKernelGGL(hymba_fwd<0>, dim3(grid), dim3(NWAVES * 64), LDS_BYTES, stream, a); break;
            case 1: hipLaunchKernelGGL(hymba_fwd<1>, dim3(grid), dim3(NWAVES * 64), LDS_BYTES, stream, a); break;
            case 2: hipLaunchKernelGGL(hymba_fwd<2>, dim3(grid), dim3(NWAVES * 64), LDS_BYTES, stream, a); break;
            case 3: hipLaunchKernelGGL(hymba_fwd<3>, dim3(grid), dim3(NWAVES * 64), LDS_BYTES, stream, a); break;
            case 4: hipLaunchKernelGGL(hymba_fwd<4>, dim3(grid), dim3(NWAVES * 64), LDS_BYTES, stream, a); break;
            case 5: hipLaunchKernelGGL(hymba_fwd<5>, dim3(grid), dim3(NWAVES * 64), LDS_BYTES, stream, a); break;
            case 10: hipLaunchKernelGGL(hymba_fwd<10>, dim3(grid), dim3(NWAVES * 64), LDS_BYTES, stream, a); break;
            default: hipLaunchKernelGGL(hymba_fwd<11>, dim3(grid), dim3(NWAVES * 64), LDS_BYTES, stream, a); break;
        }
    }
#endif
}
```
